# Optimizing an MI355X kernel written in HIP

```python
import math
import jax, jax.numpy as jnp
from jax import lax
import numpy as np

D_MODEL = 1024
BATCH = 2
SEQ = 16384
DEPTH = 2

GRID_W = 64
CTX_LEN = 256
N_EVEN = (DEPTH + 1) // 2
N_ODD = DEPTH // 2
N_MOD = 6
EPS = 1e-6
Q_BLOCK = 128
ROPE_BASE = 10000.0

POOL_WINDOWS = (2, 4, 8, 16)
POOL_GROUP = D_MODEL // 16
POOL_WIDTH = POOL_GROUP * len(POOL_WINDOWS)
DIFF_HEAD_DIM = 64
DIFF_V_DIM = 2 * DIFF_HEAD_DIM
DIFF_HEADS = (D_MODEL - POOL_WIDTH) // DIFF_V_DIM
DIFF_QK_WIDTH = DIFF_HEADS * 2 * DIFF_HEAD_DIM
DIFF_V_WIDTH = DIFF_HEADS * DIFF_V_DIM
EVEN_IN_WIDTH = POOL_WIDTH + 2 * DIFF_QK_WIDTH + DIFF_V_WIDTH
EVEN_MIX_WIDTH = POOL_WIDTH + DIFF_V_WIDTH
MLA_HEADS = D_MODEL // 128
MLA_NOPE = 128
MLA_ROPE = 64
MLA_V = 128
MLA_Q_RANK = D_MODEL // 2
MLA_KV_RANK = D_MODEL // 4
ODD_IN_WIDTH = MLA_Q_RANK + MLA_KV_RANK + MLA_ROPE
MLA_MIX_WIDTH = MLA_HEADS * MLA_V
FFN_HIDDEN = ((8 * D_MODEL // 3 + 255) // 256) * 256
N_EXPERTS = 8
TOP_K = 2

kernel_name = "hybrid_pool_diffattn_mla_moe_prefix_dit"

F32 = jnp.float32


def rmsnorm(h, g=None):
    hf = h.astype(F32)
    y = hf * lax.rsqrt(jnp.mean(hf * hf, axis=-1, keepdims=True) + EPS)
    if g is not None:
        y = y * g.astype(F32)
    return y.astype(h.dtype)


def adaln(cond, w, b):
    return jax.nn.silu(cond) @ w + b


def modulate(h, shift, scale):
    return h * (1.0 + scale) + shift


def axial_rope_tables(rows, dim):
    t = jnp.arange(rows * GRID_W, dtype=jnp.int32)
    row = (t // GRID_W).astype(F32)
    col = (t % GRID_W).astype(F32)
    quarter = dim // 4
    inv = ROPE_BASE ** (-jnp.arange(quarter, dtype=F32) / quarter)
    ar = row[:, None] * inv[None, :]
    ac = col[:, None] * inv[None, :]
    cos = jnp.concatenate([jnp.cos(ar), jnp.cos(ar), jnp.cos(ac), jnp.cos(ac)], axis=-1)
    sin = jnp.concatenate([jnp.sin(ar), jnp.sin(ar), jnp.sin(ac), jnp.sin(ac)], axis=-1)
    return cos, sin


def apply_axial_rope(u, cos, sin):
    u1, u2, u3, u4 = jnp.split(u, 4, axis=-1)
    rot = jnp.concatenate([-u2, u1, -u4, u3], axis=-1)
    return (u.astype(F32) * cos + rot.astype(F32) * sin).astype(u.dtype)


def sweep_query_blocks(fn, qs):
    b, l = qs[0].shape[:2]
    nb = l // Q_BLOCK
    blocked = tuple(jnp.moveaxis(q.reshape((b, nb, Q_BLOCK) + q.shape[2:]), 1, 0) for q in qs)
    out = lax.map(lambda qb: fn(*qb), blocked)
    return jnp.moveaxis(out, 0, 1).reshape((b, l) + out.shape[3:])


def softmax_attn_block(q, k, v, scale):
    s = jnp.einsum('bqhd,bkhd->bhqk', q, k).astype(F32) * scale
    p = jax.nn.softmax(s, axis=-1)
    return jnp.einsum('bhqk,bkhe->bqhe', p.astype(v.dtype), v)


def diff_attn_block(q1, q2, k1, k2, v, lam):
    scale = DIFF_HEAD_DIM ** -0.5
    s1 = jnp.einsum('bqhd,bkhd->bhqk', q1, k1).astype(F32) * scale
    s2 = jnp.einsum('bqhd,bkhd->bhqk', q2, k2).astype(F32) * scale
    a = jax.nn.softmax(s1, axis=-1) - lam * jax.nn.softmax(s2, axis=-1)
    return jnp.einsum('bhqk,bkhe->bqhe', a.astype(v.dtype), v)


def multiscale_pool(u, pool_w, pool_scale):
    b, l, _ = u.shape
    uf = u.astype(F32)
    cs = jnp.concatenate([jnp.zeros((b, 1, POOL_WIDTH), F32), jnp.cumsum(uf, axis=1)], axis=1)
    t = jnp.arange(l)
    outs = []
    for g, w in enumerate(POOL_WINDOWS):
        lo = jnp.clip(t - w // 2, 0, l)
        hi = jnp.clip(t + w // 2, 0, l)
        sl = slice(g * POOL_GROUP, (g + 1) * POOL_GROUP)
        csg = cs[:, :, sl]
        s = jnp.take(csg, hi, axis=1) - jnp.take(csg, lo, axis=1)
        cnt = (hi - lo).astype(F32)[None, :, None]
        outs.append(s / cnt - uf[:, :, sl])
    p = jnp.stack(outs, axis=2).astype(u.dtype)
    y = jnp.einsum('blgc,gcd->blgd', p, pool_w).reshape(b, l, POOL_WIDTH)
    return y * pool_scale


def split_even(z):
    n = z.shape[:2]
    o = POOL_WIDTH
    p = z[..., :o]
    q = z[..., o:o + DIFF_QK_WIDTH].reshape(n + (DIFF_HEADS, 2, DIFF_HEAD_DIM))
    k = z[..., o + DIFF_QK_WIDTH:o + 2 * DIFF_QK_WIDTH].reshape(n + (DIFF_HEADS, 2, DIFF_HEAD_DIM))
    v = z[..., o + 2 * DIFF_QK_WIDTH:].reshape(n + (DIFF_HEADS, DIFF_V_DIM))
    return p, q, k, v


def even_merge(p, attn, pool_w, pool_scale, w_out, lam_init):
    b, l = p.shape[:2]
    pooled = multiscale_pool(p, pool_w, pool_scale)
    heads = (rmsnorm(attn) * (1.0 - lam_init)).reshape(b, l, DIFF_V_WIDTH)
    return jnp.concatenate([pooled, heads], axis=-1) @ w_out


def even_mixer(a_lat, a_ctx, w_in, pool_w, pool_scale, lq1, lk1, lq2, lk2, w_out,
               cos, sin, lam_init, need_ctx):
    p_lat, q_lat, k_lat, v_lat = split_even(a_lat @ w_in)
    p_ctx, q_ctx, k_ctx, v_ctx = split_even(a_ctx @ w_in)
    cs, sn = cos[None, :, None, None, :], sin[None, :, None, None, :]
    q_lat = apply_axial_rope(q_lat, cs, sn)
    k_lat = apply_axial_rope(k_lat, cs, sn)
    lam = (jnp.exp(jnp.sum(lq1.astype(F32) * lk1.astype(F32)))
           - jnp.exp(jnp.sum(lq2.astype(F32) * lk2.astype(F32))) + lam_init)
    k_all = jnp.concatenate([k_lat, k_ctx], axis=1)
    v_all = jnp.concatenate([v_lat, v_ctx], axis=1)
    k1, k2 = k_all[..., 0, :], k_all[..., 1, :]
    attn_lat = sweep_query_blocks(
        lambda b1, b2: diff_attn_block(b1, b2, k1, k2, v_all, lam),
        (q_lat[..., 0, :], q_lat[..., 1, :]))
    y_lat = even_merge(p_lat, attn_lat, pool_w, pool_scale, w_out, lam_init)
    y_ctx = None
    if need_ctx:
        attn_ctx = diff_attn_block(q_ctx[..., 0, :], q_ctx[..., 1, :],
                                   k_ctx[..., 0, :], k_ctx[..., 1, :], v_ctx, lam)
        y_ctx = even_merge(p_ctx, attn_ctx, pool_w, pool_scale, w_out, lam_init)
    return y_lat, y_ctx


def odd_mixer(a_lat, a_ctx, w_in, q_norm_g, kv_norm_g, w_uq, w_ukv, w_out, cos, sin, need_ctx):
    z_lat = a_lat @ w_in
    z_ctx = a_ctx @ w_in

    def queries(z):
        cq = rmsnorm(z[..., :MLA_Q_RANK], q_norm_g)
        return (cq @ w_uq).reshape(z.shape[:2] + (MLA_HEADS, MLA_NOPE + MLA_ROPE))

    def keys_values(z):
        ckv = rmsnorm(z[..., MLA_Q_RANK:MLA_Q_RANK + MLA_KV_RANK], kv_norm_g)
        kv = (ckv @ w_ukv).reshape(z.shape[:2] + (MLA_HEADS, MLA_NOPE + MLA_V))
        return kv[..., :MLA_NOPE], kv[..., MLA_NOPE:], z[..., MLA_Q_RANK + MLA_KV_RANK:]

    def full_keys(k_nope, k_rope):
        shared = jnp.broadcast_to(k_rope[:, :, None, :], k_nope.shape[:3] + (MLA_ROPE,))
        return jnp.concatenate([k_nope, shared], axis=-1)

    q_lat = queries(z_lat)
    q_lat = jnp.concatenate(
        [q_lat[..., :MLA_NOPE],
         apply_axial_rope(q_lat[..., MLA_NOPE:], cos[None, :, None, :], sin[None, :, None, :])],
        axis=-1)
    kn_lat, v_lat, kr_lat = keys_values(z_lat)
    kr_lat = apply_axial_rope(kr_lat, cos[None], sin[None])
    kn_ctx, v_ctx, kr_ctx = keys_values(z_ctx)
    k_ctx = full_keys(kn_ctx, kr_ctx)
    k_all = jnp.concatenate([full_keys(kn_lat, kr_lat), k_ctx], axis=1)
    v_all = jnp.concatenate([v_lat, v_ctx], axis=1)
    scale = (MLA_NOPE + MLA_ROPE) ** -0.5
    b, l = a_lat.shape[:2]
    o_lat = sweep_query_blocks(lambda qb: softmax_attn_block(qb, k_all, v_all, scale), (q_lat,))
    y_lat = o_lat.reshape(b, l, MLA_MIX_WIDTH) @ w_out
    y_ctx = None
    if need_ctx:
        o_ctx = softmax_attn_block(queries(z_ctx), k_ctx, v_ctx, scale)
        y_ctx = o_ctx.reshape(a_ctx.shape[:2] + (MLA_MIX_WIDTH,)) @ w_out
    return y_lat, y_ctx


def swiglu(h, w_gate, w_up, w_down):
    return (jax.nn.silu(h @ w_gate) * (h @ w_up)) @ w_down


def moe_swiglu(h, router_w, w_gate, w_up, w_down):
    b, l, d = h.shape
    tok = h.reshape(-1, d)
    n = tok.shape[0]
    probs = jax.nn.softmax((tok @ router_w).astype(F32), axis=-1)
    top_p, top_e = lax.top_k(probs, TOP_K)
    top_p = top_p / jnp.sum(top_p, axis=-1, keepdims=True)
    flat_e = top_e.reshape(-1)
    order = jnp.argsort(flat_e)
    tok_idx = order // TOP_K
    xs = tok[tok_idx]
    group_sizes = jnp.bincount(flat_e, length=N_EXPERTS).astype(jnp.int32)
    hg = lax.ragged_dot(xs, w_gate, group_sizes)
    hu = lax.ragged_dot(xs, w_up, group_sizes)
    ys = lax.ragged_dot(jax.nn.silu(hg) * hu, w_down, group_sizes)
    wts = top_p.reshape(-1)[order].astype(ys.dtype)
    out = jax.ops.segment_sum(ys * wts[:, None], tok_idx, num_segments=n)
    return out.reshape(b, l, d)


def setup_inputs(seed: int = 0) -> dict:
    key = jax.random.key(seed)
    ks = iter(jax.random.split(key, 48))
    D = D_MODEL
    F = FFN_HIDDEN

    def nrm(shape, s):
        return jax.random.normal(next(ks), shape, jnp.float32) * s

    return {
        "x": nrm((BATCH, SEQ, D), 1.0),
        "c": nrm((BATCH, D), 1.0),
        "ctx": nrm((BATCH, CTX_LEN, D), 1.0),
        "c_ctx": nrm((D,), 1.0),
        "norm1_g": 1.0 + nrm((DEPTH, D), 0.1),
        "norm2_g": 1.0 + nrm((DEPTH, D), 0.1),
        "mod_w": nrm((DEPTH, D, N_MOD * D), 0.5 * D ** -0.5),
        "mod_b": nrm((DEPTH, N_MOD * D), 0.01),
        "even_w_in": nrm((N_EVEN, D, EVEN_IN_WIDTH), D ** -0.5),
        "pool_w": nrm((N_EVEN, len(POOL_WINDOWS), POOL_GROUP, POOL_GROUP), POOL_GROUP ** -0.5),
        "pool_scale": 1.0 + nrm((N_EVEN, POOL_WIDTH), 0.1),
        "lambda_q1": nrm((N_EVEN, DIFF_HEAD_DIM), 0.1),
        "lambda_k1": nrm((N_EVEN, DIFF_HEAD_DIM), 0.1),
        "lambda_q2": nrm((N_EVEN, DIFF_HEAD_DIM), 0.1),
        "lambda_k2": nrm((N_EVEN, DIFF_HEAD_DIM), 0.1),
        "even_w_out": nrm((N_EVEN, EVEN_MIX_WIDTH, D), EVEN_MIX_WIDTH ** -0.5),
        "ffn_w_gate": nrm((N_EVEN, D, F), D ** -0.5),
        "ffn_w_up": nrm((N_EVEN, D, F), D ** -0.5),
        "ffn_w_down": nrm((N_EVEN, F, D), F ** -0.5),
        "odd_w_in": nrm((N_ODD, D, ODD_IN_WIDTH), D ** -0.5),
        "q_norm_g": 1.0 + nrm((N_ODD, MLA_Q_RANK), 0.1),
        "kv_norm_g": 1.0 + nrm((N_ODD, MLA_KV_RANK), 0.1),
        "w_uq": nrm((N_ODD, MLA_Q_RANK, MLA_HEADS * (MLA_NOPE + MLA_ROPE)), MLA_Q_RANK ** -0.5),
        "w_ukv": nrm((N_ODD, MLA_KV_RANK, MLA_HEADS * (MLA_NOPE + MLA_V)), MLA_KV_RANK ** -0.5),
        "odd_w_out": nrm((N_ODD, MLA_MIX_WIDTH, D), MLA_MIX_WIDTH ** -0.5),
        "router_w": nrm((N_ODD, D, N_EXPERTS), D ** -0.5),
        "moe_w_gate": nrm((N_ODD, N_EXPERTS, D, F), D ** -0.5),
        "moe_w_up": nrm((N_ODD, N_EXPERTS, D, F), D ** -0.5),
        "moe_w_down": nrm((N_ODD, N_EXPERTS, F, D), F ** -0.5),
        "final_norm_g": 1.0 + nrm((D,), 0.1),
    }


def reference(x, c, ctx, c_ctx, norm1_g, norm2_g, mod_w, mod_b, even_w_in, pool_w, pool_scale,
              lambda_q1, lambda_k1, lambda_q2, lambda_k2, even_w_out, ffn_w_gate, ffn_w_up,
              ffn_w_down, odd_w_in, q_norm_g, kv_norm_g, w_uq, w_ukv, odd_w_out, router_w,
              moe_w_gate, moe_w_up, moe_w_down, final_norm_g):
    rows = x.shape[1] // GRID_W
    cos_d, sin_d = axial_rope_tables(rows, DIFF_HEAD_DIM)
    cos_m, sin_m = axial_rope_tables(rows, MLA_ROPE)
    h_lat, h_ctx = x, ctx
    for i in range(DEPTH):
        need_ctx = i < DEPTH - 1
        j = i // 2
        mod_lat = adaln(c, mod_w[i], mod_b[i])[:, None, :]
        mod_ctx = adaln(c_ctx, mod_w[i], mod_b[i])[None, None, :]
        sh1, sc1, g1, sh2, sc2, g2 = jnp.split(mod_lat, N_MOD, axis=-1)
        csh1, csc1, cg1, csh2, csc2, cg2 = jnp.split(mod_ctx, N_MOD, axis=-1)
        a_lat = modulate(rmsnorm(h_lat, norm1_g[i]), sh1, sc1)
        a_ctx = modulate(rmsnorm(h_ctx, norm1_g[i]), csh1, csc1)
        if i % 2 == 0:
            lam_init = 0.8 - 0.6 * math.exp(-0.3 * i)
            y_lat, y_ctx = even_mixer(a_lat, a_ctx, even_w_in[j], pool_w[j], pool_scale[j],
                                      lambda_q1[j], lambda_k1[j], lambda_q2[j], lambda_k2[j],
                                      even_w_out[j], cos_d, sin_d, lam_init, need_ctx)
            ffn = lambda h: swiglu(h, ffn_w_gate[j], ffn_w_up[j], ffn_w_down[j])
        else:
            y_lat, y_ctx = odd_mixer(a_lat, a_ctx, odd_w_in[j], q_norm_g[j], kv_norm_g[j],
                                     w_uq[j], w_ukv[j], odd_w_out[j], cos_m, sin_m, need_ctx)
            ffn = lambda h: moe_swiglu(h, router_w[j], moe_w_gate[j], moe_w_up[j], moe_w_down[j])
        h_lat = h_lat + g1 * y_lat
        h_lat = h_lat + g2 * ffn(modulate(rmsnorm(h_lat, norm2_g[i]), sh2, sc2))
        if need_ctx:
            h_ctx = h_ctx + cg1 * y_ctx
            h_ctx = h_ctx + cg2 * ffn(modulate(rmsnorm(h_ctx, norm2_g[i]), csh2, csc2))
    return rmsnorm(h_lat, final_norm_g)
```

```cpp
#include <hip/hip_runtime.h>
#include <cstdio>
#include <cstdint>

#define GAS __attribute__((address_space(1)))
#define LAS __attribute__((address_space(3)))
typedef unsigned short bf16_t;
typedef short bf16x8 __attribute__((ext_vector_type(8)));
typedef short s16x4 __attribute__((ext_vector_type(4)));
typedef float f32x4 __attribute__((ext_vector_type(4)));
typedef float f32x2 __attribute__((ext_vector_type(2)));
typedef float f32x16 __attribute__((ext_vector_type(16)));
typedef unsigned u32x4 __attribute__((ext_vector_type(4)));
typedef unsigned u32x2 __attribute__((ext_vector_type(2)));

constexpr int D = 1024, NB = 2, SEQ = 16384, CTX = 256, NLAT = NB * SEQ, NCTX = NB * CTX, NROW = NLAT + NCTX;
constexpr int FF = 2816, NEXP = 8, NMOD = 6 * D;
constexpr int NW = 8, NTHR = 512;
constexpr float EPS = 1e-6f;
constexpr float LOG2E = 1.4426950408889634f;
constexpr float QSC0 = 0.125f * LOG2E;
constexpr float QSC1 = 0.07216878364870322f * LOG2E;
constexpr float LAM_INIT0 = 0.2f;

constexpr size_t MiB = 1u << 20;
constexpr size_t WS_CTL = 0, CTL_ZERO_BYTES = 2 * MiB;
constexpr int CW_BAR = 4096;
constexpr int CW_CNT = 8192;
constexpr size_t CTL_SSQQ = 256 * 1024, CTL_SSQKV = 512 * 1024;
constexpr size_t WS_TAB = 2 * MiB;
constexpr size_t TAB_ROPE = 256 * 1024, TAB_IDX = 1 * MiB, TAB_WGT = 3 * MiB;
constexpr size_t WS_HC = 10 * MiB;
constexpr size_t WS_W = 12 * MiB;
constexpr size_t W_IN0 = 0, W_OUT0 = 5 * MiB, W_GU0 = 7 * MiB, W_DN0 = 18 * MiB, W_IN1 = 24 * MiB, W_UQ = 26 * MiB, W_UKV = 28 * MiB, W_OUT1 = 29 * MiB;
constexpr size_t WS_A = 44 * MiB;
constexpr size_t WS_BIG = 109 * MiB;
constexpr size_t B_P = 0, B_Q = (size_t)NROW * 256 * 4, B_K = B_Q + (size_t)NROW * 768 * 2, B_V = B_K + (size_t)NROW * 768 * 2, B_MIX = B_V + (size_t)NROW * 768 * 2;
constexpr size_t B_HID = 0;
constexpr size_t B_CQ = 0, B_CKV = B_CQ + (size_t)NROW * 512 * 2, B_KR = B_CKV + (size_t)NROW * 256 * 2, B_Q1 = 53 * MiB, B_KV1 = 149 * MiB;
constexpr size_t B_VT1 = 279 * MiB;
static_assert(B_KR + (size_t)NROW * 64 * 2 <= B_Q1 && B_VT1 + (size_t)1024 * NROW * 2 <= 387 * MiB, "L1 map");
constexpr size_t ESTRIDE = (size_t)2 * FF * D + (size_t)D * FF;
constexpr size_t B_WM = 0, B_HIDM = 132 * MiB, B_XS = 319 * MiB, BIG_END = 387 * MiB;
constexpr int MAXPAN = 136;
static_assert(NEXP * ESTRIDE * 2 <= B_HIDM && B_HIDM + (size_t)MAXPAN * 256 * FF * 2 <= B_XS && B_XS + (size_t)MAXPAN * 256 * D * 2 <= BIG_END, "MoE map");
constexpr size_t WS_END = WS_BIG + BIG_END;

constexpr int RING_BYTES = 131072, MISC_OFF = 156 * 1024, LDS_BYTES = MISC_OFF + 4096;

#define LDS_WAIT() asm volatile("s_waitcnt lgkmcnt(0)" ::: "memory")
#define VM_WAIT() asm volatile("s_waitcnt vmcnt(0)" ::: "memory")
__device__ __forceinline__ unsigned f2bf(float f) { unsigned u = __builtin_bit_cast(unsigned, f); return (u + 0x7fffu + ((u >> 16) & 1u)) >> 16; }
__device__ __forceinline__ unsigned pk2(float lo, float hi) { return f2bf(lo) | (f2bf(hi) << 16); }
__device__ __forceinline__ unsigned cvtpk(float lo, float hi) { unsigned r; asm volatile("v_cvt_pk_bf16_f32 %0, %1, %2" : "=v"(r) : "v"(lo), "v"(hi)); return r; }
__device__ __forceinline__ int opaque_tid() { int t = threadIdx.x; asm volatile("" : "+v"(t)); return t; }
__device__ __forceinline__ float wave_sum(float v) {
#pragma unroll
    for (int o = 1; o < 64; o <<= 1) v += __shfl_xor(v, o);
    return v;
}

#define XB_TMO      128
#define XB_XCNT(j)  (256  + 64 * (j))
#define XB_XSUB(j)  (1280 + 64 * (j))
#define XB_XGEN(j)  (2304 + 64 * (j))
#define XB_TOP      3328
#define XB_TOPGEN   3392
#define XCD_BAR_WORDS 3456
#define XB_SPIN_CAP (1u << 18)
__device__ __forceinline__ unsigned xb_ld(unsigned* p)              { return __hip_atomic_load(p, __ATOMIC_RELAXED, __HIP_MEMORY_SCOPE_AGENT); }
__device__ __forceinline__ unsigned xb_add(unsigned* p, unsigned v) { return __hip_atomic_fetch_add(p, v, __ATOMIC_RELAXED, __HIP_MEMORY_SCOPE_AGENT); }
__device__ __forceinline__ unsigned xb_xcc_id() { return (unsigned)__builtin_amdgcn_s_getreg((3 << 11) | 20) & 0xFu; }
#define XB_SPIN(cond, bar) do { unsigned _sp = 0; while (cond) { __builtin_amdgcn_s_sleep(1); \
    if ((++_sp & 255u) == 0u) { if (xb_ld(&(bar)[XB_TMO])) break; if (_sp > XB_SPIN_CAP) { atomicAdd(&(bar)[XB_TMO], 1u); break; } } } } while (0)
struct XcdBarrier { unsigned* bar; unsigned x; volatile LAS unsigned* st; };
__device__ __forceinline__ XcdBarrier xcd_barrier_post(unsigned* bar, volatile LAS unsigned* st) {
    XcdBarrier b; b.bar = bar; b.x = xb_xcc_id(); b.st = st;
    if (threadIdx.x == 0) (void)xb_add(&bar[XB_XCNT(b.x)], 1u);
    return b;
}
__device__ __forceinline__ void xcd_barrier_complete(unsigned* bar, unsigned x, unsigned& nloc, unsigned& nx) {
    const unsigned G = gridDim.x * gridDim.y * gridDim.z;
    unsigned sum, cnt, mine, sp = 0u;
    for (;;) {
        sum = 0u; cnt = 0u; mine = 0u;
#pragma unroll
        for (unsigned j = 0; j < 16; ++j) { const unsigned c = xb_ld(&bar[XB_XCNT(j)]); sum += c; cnt += (c > 0u) ? 1u : 0u; mine = (j == x) ? c : mine; }
        if (sum == G) break;
        __builtin_amdgcn_s_sleep(1);
        if ((++sp & 255u) == 0u) { if (xb_ld(&bar[XB_TMO])) break; if (sp > XB_SPIN_CAP) { atomicAdd(&bar[XB_TMO], 1u); break; } }
    }
    nloc = mine > 0u ? mine : 1u; nx = cnt > 0u ? cnt : 1u;
}
__device__ __forceinline__ void xcd_barrier(const XcdBarrier& b) {
    asm volatile("s_waitcnt vmcnt(0)" ::: "memory");
    __syncthreads();
    if (threadIdx.x == 0) {
        unsigned* bar = b.bar;
        __builtin_amdgcn_s_waitcnt(0);
        unsigned nloc = b.st[0], nx = b.st[1];
        if (nloc == 0u) { xcd_barrier_complete(bar, b.x, nloc, nx); b.st[0] = nloc; b.st[1] = nx; }
        const unsigned old = xb_add(&bar[XB_XSUB(b.x)], 1u);
        const unsigned gen = old / nloc;
        if (old + 1u == (gen + 1u) * nloc) {
            __builtin_amdgcn_fence(__ATOMIC_RELEASE, "agent");
            asm volatile("s_waitcnt vmcnt(0)" ::: "memory");
            const unsigned og = xb_add(&bar[XB_TOP], 1u);
            const unsigned tg = og / nx;
            if (og + 1u == (tg + 1u) * nx) xb_add(&bar[XB_TOPGEN], 1u);
            else XB_SPIN(xb_ld(&bar[XB_TOPGEN]) == tg, bar);
            __builtin_amdgcn_fence(__ATOMIC_ACQUIRE, "agent");
            xb_add(&bar[XB_XGEN(b.x)], 1u);
            asm volatile("s_waitcnt vmcnt(0)" ::: "memory");
        } else {
            XB_SPIN(xb_ld(&bar[XB_XGEN(b.x)]) == gen, bar);
            __builtin_amdgcn_fence(__ATOMIC_ACQUIRE, "agent");
            asm volatile("s_waitcnt vmcnt(0)" ::: "memory");
        }
    }
    __syncthreads();
}

namespace pg8 {
constexpr int BM = 256, BK = 64, HALF = 128, HTB = HALF * BK * 2, STAGE_BYTES = 8 * HTB, NXCD = 8, WGM = 4;
__host__ __device__ __forceinline__ int lds_byte(int r, int c) { const int st = (r >> 4) * 2 + (c >> 5), rr = r & 15, cc = c & 31, ob = rr * 64 + cc * 2; return st * 1024 + (ob ^ (((ob >> 9) & 1) << 5)); }
__host__ __device__ __forceinline__ void stage_rc(int b, int& R, int& C) { const int st = b / 1024, sb = b % 1024, swz = sb ^ (((sb >> 9) & 1) << 5); R = (st >> 1) * 16 + swz / 64; C = (st & 1) * 32 + (swz % 64) / 2; }
__host__ __device__ __forceinline__ int perm32(int rho) { const int n = rho >> 4, i = rho & 15; return 8 * (i >> 2) + 4 * n + (i & 3); }
struct Unit { int pm, pn; };
struct Gemm { const bf16_t* A; const bf16_t* Bt; int M, N, K; const volatile LAS int* pb; size_t estride; const int* gidx; const volatile LAS int* gcnt; };
constexpr int TOKBUF = 152 * 1024;
#ifndef TAIL_MAX
#define TAIL_MAX 64
#endif
struct StaticOrder {
    int nM, nN, nwg, G, c, nmain;
    __host__ __device__ void init(int M, int N, int G_, int c_) { nM = M / BM; nN = N / BM; nwg = nM * nN; G = G_; c = c_; const int rem = nwg % G; nmain = (rem > 0 && rem <= TAIL_MAX) ? nwg - rem : nwg; }
    __host__ __device__ bool next(int i, Unit& u) const {
        const long L = (long)i * G + c; if (L >= nmain) return false;
        map((int)L, u); return true;
    }
    __host__ __device__ void map(int L, Unit& u) const {
        int wgid = L; { const int q = nwg / NXCD, r = nwg % NXCD, xcd = wgid % NXCD, off = wgid / NXCD; wgid = (xcd < r ? xcd * (q + 1) : r * (q + 1) + (xcd - r) * q) + off; }
        const int nig = WGM * nN, gid = wgid / nig, fm = gid * WGM, gsz = (nM - fm) < WGM ? (nM - fm) : WGM;
        u.pm = fm + ((wgid % nig) % gsz); u.pn = (wgid % nig) / gsz;
    }
};
__device__ __forceinline__ const char* b_tile(const Gemm& g, const Unit& u, size_t tstep) {
    const char* p = (const char*)g.Bt + (size_t)u.pn * tstep;
    if (g.pb) { int e = 0;
#pragma unroll
        for (int k = 1; k < 8; ++k) e += (u.pm >= g.pb[k]) ? 1 : 0;
        p += (size_t)e * g.estride * 2; }
    return p;
}

template <class Epi, bool ALIGN_EPI = false, bool SP2 = false, bool GATH = false>
__device__ __forceinline__ void gemm_phase(LAS unsigned char* lds, const Gemm g, const StaticOrder& S, const Epi& E) {
    static_assert(!GATH || SP2, "gathered A rows: SP2 loop only");
    const int tid = opaque_tid(), wid = __builtin_amdgcn_readfirstlane(tid >> 6), lane = tid & 63, wr = wid >> 2, wc = wid & 3, fr = lane & 15, fq = lane >> 4;
    const int K = g.K, nt = K / BK;
    unsigned voffA[2], voffB[2];
#pragma unroll
    for (int i = 0; i < 2; ++i) { int R, C; stage_rc(tid * 16 + i * 8192, R, C); const int Rb = Epi::PERM ? ((R & ~31) + perm32(R & 31)) : R;
        voffA[i] = (unsigned)(R * K + C) * 2u; voffB[i] = (unsigned)(Rb * K + C) * 2u; }
    const size_t kstep = (size_t)(BK * 2);
    const size_t hstep = (size_t)HALF * K * 2;
    const size_t tstep = 2 * hstep;
    const unsigned ldsw = (unsigned)wid * 1024u;
    const int aoff = lds_byte(wr * 64 + fr, fq * 8), boff = lds_byte(wc * 32 + fr, fq * 8);
#define PG8_SA(b, h) (((b) * 2 + (h)) * HTB)
#define PG8_SB(b, h) ((4 + (b) * 2 + (h)) * HTB)
#define PG8_STAGE(bufoff, gbase, voff) do { _Pragma("unroll") for (int _i = 0; _i < 2; ++_i) \
        __builtin_amdgcn_global_load_lds((const unsigned*)((const char*)(gbase) + (voff)[_i]), (LAS unsigned*)(lds + (bufoff) + ldsw + _i * 8192), 16, 0, 0); } while (0)
#define PG8_STAGE_A(bufoff, base, h, vv) do { if constexpr (GATH) PG8_STAGE(bufoff, base, (vv)[h]); else PG8_STAGE(bufoff, (base) + (h) * hstep, voffA); } while (0)
#define PG8_LDA(dst, b, h) do { _Pragma("unroll") for (int m = 0; m < 4; ++m) _Pragma("unroll") for (int k = 0; k < 2; ++k) dst[m][k] = *(const LAS bf16x8*)(lds + PG8_SA(b, h) + aoff + m * 2048 + k * 1024); } while (0)
#define PG8_LDB(dst, b, h) do { _Pragma("unroll") for (int n = 0; n < 2; ++n) _Pragma("unroll") for (int k = 0; k < 2; ++k) dst[n][k] = *(const LAS bf16x8*)(lds + PG8_SB(b, h) + boff + n * 2048 + k * 1024); } while (0)
#define PG8_MMA(ai, bj, At, Bt) do { __builtin_amdgcn_s_setprio(1); _Pragma("unroll") for (int m = 0; m < 4; ++m) _Pragma("unroll") for (int n = 0; n < 2; ++n) _Pragma("unroll") for (int k = 0; k < 2; ++k) \
        acc[ai][bj][m][n] = __builtin_amdgcn_mfma_f32_16x16x32_bf16(Bt[n][k], At[m][k], acc[ai][bj][m][n], 0, 0, 0); __builtin_amdgcn_s_setprio(0); } while (0)
#define PG8_WAIT_V(n) asm volatile("s_waitcnt vmcnt(" #n ")" ::: "memory")
#define PG8_WAIT_L(n) asm volatile("s_waitcnt lgkmcnt(" #n ")" ::: "memory")
#define PG8_BAR __builtin_amdgcn_s_barrier()
#define PG8_SCHED __builtin_amdgcn_sched_barrier(0)
    Unit cur, nxt; int ui = 0;
    if (!S.next(0, cur)) return;
    f32x4 acc[2][2][4][2];
#pragma unroll
    for (int a = 0; a < 2; ++a)
#pragma unroll
        for (int b = 0; b < 2; ++b)
#pragma unroll
            for (int m = 0; m < 4; ++m)
#pragma unroll
                for (int n = 0; n < 2; ++n) acc[a][b][m][n] = (f32x4){0.f, 0.f, 0.f, 0.f};
    bf16x8 At[4][2], B0[2][2], B1[2][2];
    unsigned cvA[2][2] = {{0u, 0u}, {0u, 0u}}, xvA[2][2] = {{0u, 0u}, {0u, 0u}};
    if constexpr (GATH) {
        int e = 0;
#pragma unroll
        for (int k = 1; k < 8; ++k) e += (cur.pm >= g.pb[k]) ? 1 : 0;
        const int lp = cur.pm - g.pb[e], n_e = g.gcnt[e];
#pragma unroll
        for (int i = 0; i < 2; ++i) { int R, C; stage_rc(tid * 16 + i * 8192, R, C);
#pragma unroll
            for (int h = 0; h < 2; ++h) { const int pos = lp * 256 + h * 128 + R; const int tok = pos < n_e ? g.gidx[(size_t)e * NLAT + pos] : 0; cvA[h][i] = (unsigned)(tok * K + C) * 2u; } }
    }
    const char* cA = GATH ? (const char*)g.A : (const char*)g.A + (size_t)cur.pm * tstep; const char* cB = b_tile(g, cur, tstep);
    if constexpr (SP2) {
        PG8_STAGE(PG8_SB(0, 0), cB, voffB); PG8_STAGE(PG8_SB(0, 1), cB + hstep, voffB); PG8_STAGE_A(PG8_SA(0, 0), cA, 0, cvA); PG8_STAGE_A(PG8_SA(0, 1), cA, 1, cvA);
        if (wr == 1) PG8_BAR;
        PG8_WAIT_V(2); PG8_BAR;
        PG8_STAGE(PG8_SB(1, 0), cB + kstep, voffB); PG8_STAGE_A(PG8_SA(1, 0), cA + kstep, 0, cvA); PG8_STAGE(PG8_SB(1, 1), cB + hstep + kstep, voffB);
        PG8_WAIT_V(6); PG8_BAR;
    } else {
        PG8_STAGE(PG8_SB(0, 0), cB, voffB); PG8_STAGE(PG8_SA(0, 0), cA, voffA); PG8_STAGE(PG8_SB(0, 1), cB + hstep, voffB); PG8_STAGE(PG8_SA(0, 1), cA + hstep, voffA);
        if (wr == 1) PG8_BAR;
        PG8_WAIT_V(4); PG8_BAR;
        PG8_STAGE(PG8_SB(1, 0), cB + kstep, voffB); PG8_STAGE(PG8_SA(1, 0), cA + kstep, voffA); PG8_STAGE(PG8_SB(1, 1), cB + hstep + kstep, voffB);
        PG8_WAIT_V(6); PG8_BAR;
    }
    for (;;) {
        const bool has_next = S.next(ui + 1, nxt);
        const char* nA = (has_next && !GATH) ? (const char*)g.A + (size_t)nxt.pm * tstep : cA; const char* nB = has_next ? b_tile(g, nxt, tstep) : cB;
        int ne = 0, nlp = 0, nn = 0;
        if constexpr (GATH) { if (has_next) {
#pragma unroll
            for (int k = 1; k < 8; ++k) ne += (nxt.pm >= g.pb[k]) ? 1 : 0;
            nlp = nxt.pm - g.pb[ne]; nn = g.gcnt[ne];
            if (wid == 0) __builtin_amdgcn_global_load_lds((const unsigned*)(g.gidx + (size_t)ne * NLAT + nlp * 256 + lane * 4), (LAS unsigned*)(lds + TOKBUF + ((ui + 1) & 1) * 1024), 16, 0, 0); } }
        for (int t = 0; t < nt; t += 2) {
            const bool last = (t == nt - 2);
            const char* a1 = cA + (size_t)(t + 1) * kstep;
            const char* a2 = last ? nA : cA + (size_t)(t + 2) * kstep; const char* b2 = last ? nB : cB + (size_t)(t + 2) * kstep;
            const char* a3 = a2 + kstep; const char* b3 = b2 + kstep;
            if constexpr (GATH) {
                if (last && has_next) {
                    int t2 = tid; asm volatile("" : "+v"(t2));
#pragma unroll
                    for (int i = 0; i < 2; ++i) { int R, C; stage_rc(t2 * 16 + i * 8192, R, C);
#pragma unroll
                        for (int h = 0; h < 2; ++h) { const int r = h * 128 + R; const int tok = (nlp * 256 + r < nn) ? *(const LAS int*)(lds + TOKBUF + ((ui + 1) & 1) * 1024 + r * 4) : 0; xvA[h][i] = (unsigned)(tok * K + C) * 2u; } }
                } else {
#pragma unroll
                    for (int i = 0; i < 2; ++i) { xvA[0][i] = cvA[0][i]; xvA[1][i] = cvA[1][i]; } }
            }
            if constexpr (SP2) {
            PG8_LDB(B0, 0, 0); PG8_LDB(B1, 0, 1); PG8_SCHED; PG8_LDA(At, 0, 0); PG8_STAGE_A(PG8_SA(1, 1), a1, 1, cvA);
            PG8_WAIT_V(8); PG8_WAIT_L(0); PG8_BAR; PG8_MMA(0, 0, At, B0); PG8_MMA(0, 1, At, B1); PG8_BAR; PG8_SCHED;
            PG8_LDA(At, 0, 1); PG8_STAGE(PG8_SB(0, 0), b2, voffB); PG8_STAGE(PG8_SB(0, 1), b2 + hstep, voffB); PG8_STAGE_A(PG8_SA(0, 0), a2, 0, xvA);
            PG8_WAIT_V(8); PG8_WAIT_L(0); PG8_BAR; PG8_MMA(1, 0, At, B0); PG8_MMA(1, 1, At, B1); PG8_BAR; PG8_SCHED;
            PG8_LDB(B0, 1, 0); PG8_LDB(B1, 1, 1); PG8_SCHED; PG8_LDA(At, 1, 0); PG8_STAGE_A(PG8_SA(0, 1), a2, 1, xvA);
            PG8_WAIT_V(8); PG8_WAIT_L(0); PG8_BAR; PG8_MMA(0, 0, At, B0); PG8_MMA(0, 1, At, B1); PG8_BAR; PG8_SCHED;
            PG8_LDA(At, 1, 1); PG8_STAGE(PG8_SB(1, 0), b3, voffB); PG8_STAGE(PG8_SB(1, 1), b3 + hstep, voffB); PG8_STAGE_A(PG8_SA(1, 0), a3, 0, xvA);
            PG8_WAIT_V(8); PG8_WAIT_L(0); PG8_BAR; PG8_MMA(1, 0, At, B0); PG8_MMA(1, 1, At, B1); PG8_BAR; PG8_SCHED;
            } else {
            PG8_LDB(B0, 0, 0); PG8_SCHED; PG8_LDA(At, 0, 0); PG8_STAGE(PG8_SA(1, 1), a1 + hstep, voffA);
            PG8_WAIT_L(8); PG8_BAR; PG8_WAIT_L(0); PG8_MMA(0, 0, At, B0); PG8_BAR; PG8_SCHED;
            PG8_LDB(B1, 0, 1); PG8_STAGE(PG8_SB(0, 0), b2, voffB);
            PG8_BAR; PG8_WAIT_L(0); PG8_MMA(0, 1, At, B1); PG8_BAR;
            PG8_LDA(At, 0, 1); PG8_STAGE(PG8_SA(0, 0), a2, voffA);
            PG8_BAR; PG8_WAIT_L(0); PG8_MMA(1, 0, At, B0); PG8_BAR; PG8_SCHED;
            PG8_STAGE(PG8_SB(0, 1), b2 + hstep, voffB);
            PG8_WAIT_V(6); PG8_BAR; PG8_MMA(1, 1, At, B1); PG8_BAR;
            PG8_LDB(B0, 1, 0); PG8_SCHED; PG8_LDA(At, 1, 0); PG8_STAGE(PG8_SA(0, 1), a2 + hstep, voffA);
            PG8_WAIT_L(8); PG8_BAR; PG8_WAIT_L(0); PG8_MMA(0, 0, At, B0); PG8_BAR; PG8_SCHED;
            PG8_LDB(B1, 1, 1); PG8_STAGE(PG8_SB(1, 0), b3, voffB);
            PG8_BAR; PG8_WAIT_L(0); PG8_MMA(0, 1, At, B1); PG8_BAR;
            PG8_LDA(At, 1, 1); PG8_STAGE(PG8_SA(1, 0), a3, voffA);
            PG8_BAR; PG8_WAIT_L(0); PG8_MMA(1, 0, At, B0); PG8_BAR; PG8_SCHED;
            PG8_STAGE(PG8_SB(1, 1), b3 + hstep, voffB);
            PG8_WAIT_V(6); PG8_BAR; PG8_MMA(1, 1, At, B1); PG8_BAR;
            }
        }
        if constexpr (ALIGN_EPI) { if (wr == 0) PG8_BAR; }
        E(acc, cur, wr, wc, fr, fq);
        if (!has_next) break;
#pragma unroll
        for (int a = 0; a < 2; ++a)
#pragma unroll
            for (int b = 0; b < 2; ++b)
#pragma unroll
                for (int m = 0; m < 4; ++m)
#pragma unroll
                    for (int n = 0; n < 2; ++n) acc[a][b][m][n] = (f32x4){0.f, 0.f, 0.f, 0.f};
        cur = nxt; cA = nA; cB = nB; ++ui;
        if constexpr (GATH) {
#pragma unroll
            for (int i = 0; i < 2; ++i) { cvA[0][i] = xvA[0][i]; cvA[1][i] = xvA[1][i]; } }
        if constexpr (ALIGN_EPI) { if (wr == 1) PG8_BAR; }
    }
    PG8_WAIT_V(0);
    if constexpr (!ALIGN_EPI) { if (wr == 0) PG8_BAR; }
    PG8_BAR;
#undef PG8_SA
#undef PG8_SB
#undef PG8_STAGE
#undef PG8_STAGE_A
#undef PG8_LDA
#undef PG8_LDB
#undef PG8_MMA
#undef PG8_WAIT_V
#undef PG8_WAIT_L
#undef PG8_BAR
#undef PG8_SCHED
}
template <class Epi, bool GATH = false>
__device__ __forceinline__ void gemm_tail(LAS unsigned char* lds, const Gemm g, const StaticOrder& S, const Epi& E) {
    const int ntail = S.nwg - S.nmain; if (ntail <= 0) return;
    const int tid = opaque_tid(), wid = __builtin_amdgcn_readfirstlane(tid >> 6), lane = tid & 63, wr = wid >> 2, wm = wid & 3, fr = lane & 15, fq = lane >> 4;
    const int K = g.K, nt = K / BK;
    unsigned voffA[2];
#pragma unroll
    for (int i = 0; i < 2; ++i) { int R, C; stage_rc(tid * 16 + i * 8192, R, C); voffA[i] = (unsigned)(R * K + C) * 2u; }
    const size_t kstep = (size_t)(BK * 2), hstep = (size_t)HALF * K * 2, tstep = 2 * hstep;
    const unsigned ldsw = (unsigned)wid * 1024u;
    const int aoff = lds_byte(wr * 64 + wm * 16 + fr, fq * 8), binner = lds_byte(fr, fq * 8);
    constexpr int SLOT = HTB + 8192, NS = 6, PF = NS - 1;
#define PT_DMA(src, dst) __builtin_amdgcn_global_load_lds((const unsigned*)(src), (LAS unsigned*)(dst), 16, 0, 0)
#define PT_STAGE(so, kt) do { LAS unsigned char* _l = lds + (so); const char* _a = cA + (size_t)(kt) * kstep; \
        PT_DMA(_a + voffA[0], _l + ldsw); PT_DMA(_a + voffA[1], _l + ldsw + 8192); PT_DMA(cBw + (size_t)(kt) * kstep, _l + HTB + ldsw); } while (0)
    const int nq = (ntail + 7) >> 3;
    for (int t = S.c; t < nq * 64; t += S.G) {
        const int q = (t & 7) + 8 * (t >> 6), sl = (t >> 3) & 7; if (q >= ntail) continue;
        Unit u; S.map(S.nmain + q, u); const int sai = sl >> 2, wcq = sl & 3;
        const char* cA = GATH ? (const char*)g.A : (const char*)g.A + (size_t)u.pm * tstep + (size_t)sai * hstep;
        if constexpr (GATH) {
            int e = 0;
#pragma unroll
            for (int k = 1; k < 8; ++k) e += (u.pm >= g.pb[k]) ? 1 : 0;
            const int lp = u.pm - g.pb[e], n_e = g.gcnt[e];
#pragma unroll
            for (int i = 0; i < 2; ++i) { int R, C; stage_rc(tid * 16 + i * 8192, R, C); const int pos = lp * 256 + sai * 128 + R; const int tok = pos < n_e ? g.gidx[(size_t)e * NLAT + pos] : 0; voffA[i] = (unsigned)(tok * K + C) * 2u; }
        }
        const char* cBw;
        { int R, C; stage_rc((4 * wcq + (wid & 3)) * 1024 + lane * 16, R, C); const int Rb = Epi::PERM ? ((R & ~31) + perm32(R & 31)) : R;
          cBw = b_tile(g, u, tstep) + (size_t)(wid >> 2) * hstep + (size_t)(Rb * K + C) * 2; }
        f32x4 acc[2][2][4][2];
        acc[0][0][0][0] = (f32x4){0.f, 0.f, 0.f, 0.f}; acc[0][0][0][1] = (f32x4){0.f, 0.f, 0.f, 0.f}; acc[0][1][0][0] = (f32x4){0.f, 0.f, 0.f, 0.f}; acc[0][1][0][1] = (f32x4){0.f, 0.f, 0.f, 0.f};
        for (int i = 0; i < PF && i < nt; ++i) PT_STAGE(i * SLOT, i);
        int so = 0, so2 = PF * SLOT;
        for (int kt = 0; kt < nt; ++kt) {
            const int ahead = nt - 1 - kt;
            if (ahead >= 4) asm volatile("s_waitcnt vmcnt(12)" ::: "memory"); else if (ahead == 3) asm volatile("s_waitcnt vmcnt(9)" ::: "memory");
            else if (ahead == 2) asm volatile("s_waitcnt vmcnt(6)" ::: "memory"); else if (ahead == 1) asm volatile("s_waitcnt vmcnt(3)" ::: "memory"); else asm volatile("s_waitcnt vmcnt(0)" ::: "memory");
            __builtin_amdgcn_s_barrier();
            if (kt + PF < nt) PT_STAGE(so2, kt + PF);
            bf16x8 At[2], B0[2][2], B1[2][2];
#pragma unroll
            for (int k = 0; k < 2; ++k) { At[k] = *(const LAS bf16x8*)(lds + so + aoff + k * 1024);
#pragma unroll
                for (int n = 0; n < 2; ++n) { B0[n][k] = *(const LAS bf16x8*)(lds + so + HTB + (2 * n + k) * 1024 + binner); B1[n][k] = *(const LAS bf16x8*)(lds + so + HTB + 4096 + (2 * n + k) * 1024 + binner); } }
#pragma unroll
            for (int k = 0; k < 2; ++k)
#pragma unroll
                for (int n = 0; n < 2; ++n) { acc[0][0][0][n] = __builtin_amdgcn_mfma_f32_16x16x32_bf16(B0[n][k], At[k], acc[0][0][0][n], 0, 0, 0);
                    acc[0][1][0][n] = __builtin_amdgcn_mfma_f32_16x16x32_bf16(B1[n][k], At[k], acc[0][1][0][n], 0, 0, 0); }
            so = (so == (NS - 1) * SLOT) ? 0 : so + SLOT; so2 = (so2 == (NS - 1) * SLOT) ? 0 : so2 + SLOT;
        }
        __builtin_amdgcn_s_barrier();
        E.template run<true>(acc, u, wr, wcq, fr, fq, sai, wm);
    }
#undef PT_DMA
#undef PT_STAGE
}
template <class Epi, bool ALIGN_EPI = false, bool SP2 = false, bool GATH = false>
__device__ __forceinline__ void gemm_run(LAS unsigned char* lds, const Gemm g, const StaticOrder& S, const Epi& E) { gemm_phase<Epi, ALIGN_EPI, SP2, GATH>(lds, g, S, E); gemm_tail<Epi, GATH>(lds, g, S, E); }
}
namespace epi {
using pg8::Unit;
typedef const f32x4 (&AccRef)[2][2][4][2];
__device__ __forceinline__ int vrow(int r) { return r < NLAT ? (r >> 14) : 2; }
__device__ __forceinline__ f32x4 bf4_f(unsigned lo, unsigned hi) { f32x4 r; r[0] = __uint_as_float(lo << 16); r[1] = __uint_as_float(lo & 0xffff0000u); r[2] = __uint_as_float(hi << 16); r[3] = __uint_as_float(hi & 0xffff0000u); return r; }
__device__ __forceinline__ void st_bf4(bf16_t* p, f32x4 v) { u32x2 w; w.x = cvtpk(v[0], v[1]); w.y = cvtpk(v[2], v[3]); *(u32x2*)p = w; }
__device__ __forceinline__ void rope4(f32x4& u1, f32x4& u2, const f32x2* rope, int ang, int i0) {
    const f32x4 cs0 = *(const f32x4*)(rope + ang * 16 + i0), cs1 = *(const f32x4*)(rope + ang * 16 + i0 + 2);
    const f32x4 c = {cs0[0], cs0[2], cs1[0], cs1[2]}, s = {cs0[1], cs0[3], cs1[1], cs1[3]};
    const f32x4 a = u1 * c - u2 * s, b = u2 * c + u1 * s; u1 = a; u2 = b;
}

__device__ __forceinline__ void vt_block(LAS unsigned char* scr, bf16_t* vt, const f32x4& ua, const f32x4& ub, int ca, int cb, int lane) {
    asm volatile("" : "+v"(lane));
    const bool odd = (lane & 1) != 0; const int fr = lane & 15, c0 = odd ? cb : ca;
    const f32x4 keep = odd ? ub : ua, send = odd ? ua : ub; f32x4 recv;
#pragma unroll
    for (int j = 0; j < 4; ++j) recv[j] = __shfl_xor(send[j], 1);
    const int fp = (fr & 2) | ((fr & 4) << 1) | ((fr & 8) >> 1);
#pragma unroll
    for (int j = 0; j < 4; ++j) *(LAS unsigned*)(scr + (c0 + j) * 32 + fp * 2) = odd ? cvtpk(recv[j], keep[j]) : cvtpk(keep[j], recv[j]);
    asm volatile("" ::: "memory");
    const u32x4 q = *(const LAS u32x4*)(scr + (lane >> 1) * 32 + (lane & 1) * 16);
    asm volatile("" ::: "memory");
    *(u32x4*)(vt + (size_t)(lane >> 1) * NROW + (lane & 1) * 8) = q;
}

struct EpiIn0 {
    static constexpr bool PERM = false;
    float* P; bf16_t* Q; bf16_t* K; bf16_t* V; const f32x2* rope; unsigned* kmax2; LAS unsigned char* scr;
    __device__ __forceinline__ void operator()(AccRef acc, const Unit& u, int wr, int wc, int fr, int fq) const { run<false>(acc, u, wr, wc, fr, fq, 0, 0); }
    template <bool SL> __device__ __forceinline__ void run(AccRef acc, const Unit& u, int wr, int wc, int fr, int fq, int sai, int sm) const {
        const int row0 = u.pm * 256 + wr * 64 + fr;
        if (u.pn == 0) {
#pragma unroll
            for (int ai = 0; ai < (SL ? 1 : 2); ++ai)
#pragma unroll
                for (int m = 0; m < (SL ? 1 : 4); ++m) { float* rowp = P + (size_t)(row0 + (SL ? sai : ai) * 128 + (SL ? sm : m) * 16) * 256 + wc * 32 + 4 * fq;
#pragma unroll
                    for (int bj = 0; bj < 2; ++bj)
#pragma unroll
                        for (int n = 0; n < 2; ++n) *(f32x4*)(rowp + bj * 128 + n * 16) = acc[ai][bj][m][n]; }
            return;
        }
        const int sec = (u.pn - 1) / 3, ct = (u.pn - 1) - sec * 3;
        if (sec == 2) {
            LAS unsigned char* ws_ = scr + (SL ? wr * 4 + sm : wr * 4 + wc) * 1024; const int lane = fq * 16 + fr;
#pragma unroll
            for (int ai = 0; ai < (SL ? 1 : 2); ++ai)
#pragma unroll
                for (int m = 0; m < (SL ? 1 : 4); ++m) { const int rb = row0 - fr + (SL ? sai : ai) * 128 + (SL ? sm : m) * 16;
#pragma unroll
                    for (int bj = 0; bj < 2; ++bj) vt_block(ws_, V + (size_t)((2 * ct + bj) * 128 + wc * 32) * NROW + rb, acc[ai][bj][m][0], acc[ai][bj][m][1], 4 * fq, 16 + 4 * fq, lane); }
            return;
        }
        bf16_t* base = Q + (size_t)sec * ((size_t)NROW * 768) + ct * 256 + wc * 32 + 8 * fq;
        const float sc = (sec == 0) ? QSC0 : 1.0f;
        const bool dorope = (sec < 2) && (u.pm < NLAT / 256);
        float kmx[2] = {0.f, 0.f};
#pragma unroll
        for (int ai = 0; ai < (SL ? 1 : 2); ++ai)
#pragma unroll
            for (int m = 0; m < (SL ? 1 : 4); ++m) { const int r = row0 + (SL ? sai : ai) * 128 + (SL ? sm : m) * 16; bf16_t* rowp = base + (size_t)r * 768;
                const int t = r & (SEQ - 1), ang = dorope ? ((wc & 1) ? (t & 63) : (t >> 6)) : 0;
#pragma unroll
                for (int bj = 0; bj < 2; ++bj) { f32x4 u1 = acc[ai][bj][m][0], u2 = acc[ai][bj][m][1];
                    rope4(u1, u2, rope, ang, 4 * fq);
                    if (sec == 1) { float s = ((u1[0] * u1[0] + u1[1] * u1[1]) + (u1[2] * u1[2] + u1[3] * u1[3])) + ((u2[0] * u2[0] + u2[1] * u2[1]) + (u2[2] * u2[2] + u2[3] * u2[3]));
                        s += __shfl_xor(s, 16); s += __shfl_xor(s, 32); kmx[bj] = fmaxf(kmx[bj], s); }
                    { const f32x4 y1 = u1 * sc, y2 = u2 * sc; u32x4 w; w.x = cvtpk(y1[0], y1[1]); w.y = cvtpk(y1[2], y1[3]); w.z = cvtpk(y2[0], y2[1]); w.w = cvtpk(y2[2], y2[3]); *(u32x4*)(rowp + bj * 128) = w; } } if (m == 3) asm volatile("" ::: "memory"); }
        if (sec == 1) { const int b = u.pm < NLAT / 256 ? (u.pm >> 6) : (u.pm - NLAT / 256);
#pragma unroll
            for (int bj = 0; bj < 2; ++bj) { float s = kmx[bj];
#pragma unroll
                for (int o = 1; o < 16; o <<= 1) s = fmaxf(s, __shfl_xor(s, o));
                if (fr == 0 && fq == 0) atomicMax(kmax2 + (((b * 6 + 2 * ct + bj) * 2 + (wc >> 1)) * 2 + (wc & 1)), __float_as_uint(s)); } }
    }
};
template <bool BIN>
struct EpiRes {
    static constexpr bool PERM = true;
    const void* baseL; bf16_t* outL; const void* baseC; bf16_t* outC; const float* gate;
    __device__ __forceinline__ void operator()(AccRef acc, const Unit& u, int wr, int wc, int fr, int fq) const { run<false>(acc, u, wr, wc, fr, fq, 0, 0); }
    template <bool SL> __device__ __forceinline__ void run(AccRef acc, const Unit& u, int wr, int wc, int fr, int fq, int sai, int sm) const {
        const bool lat = u.pm < NLAT / 256;
        const int rbase = lat ? 0 : NLAT;
        const void* bp = lat ? baseL : baseC; bf16_t* op = lat ? outL : outC;
        const int v = lat ? (u.pm >> 6) : 2;
        const int col0 = u.pn * 256 + wc * 32 + 8 * fq, row0 = u.pm * 256 - rbase + wr * 64 + fr;
        f32x4 gv[2][2];
#pragma unroll
        for (int bj = 0; bj < 2; ++bj)
#pragma unroll
            for (int n = 0; n < 2; ++n) gv[bj][n] = *(const f32x4*)(gate + v * NMOD + col0 + bj * 128 + 4 * n);
#pragma unroll
        for (int ai = 0; ai < (SL ? 1 : 2); ++ai)
#pragma unroll
            for (int m = 0; m < (SL ? 1 : 4); ++m) { const size_t off = (size_t)(row0 + (SL ? sai : ai) * 128 + (SL ? sm : m) * 16) * D + col0;
#pragma unroll
                for (int bj = 0; bj < 2; ++bj) { f32x4 b0, b1;
                    if constexpr (BIN) { const u32x4 w = *(const u32x4*)((const bf16_t*)bp + off + bj * 128); b0 = bf4_f(w.x, w.y); b1 = bf4_f(w.z, w.w); }
                    else { b0 = *(const f32x4*)((const float*)bp + off + bj * 128); b1 = *(const f32x4*)((const float*)bp + off + bj * 128 + 4); }
                    const f32x4 r0 = b0 + gv[bj][0] * acc[ai][bj][m][0], r1 = b1 + gv[bj][1] * acc[ai][bj][m][1];
                    u32x4 o; o.x = cvtpk(r0[0], r0[1]); o.y = cvtpk(r0[2], r0[3]); o.z = cvtpk(r1[0], r1[1]); o.w = cvtpk(r1[2], r1[3]);
                    *(u32x4*)(op + off + bj * 128) = o; } if (m & 1) asm volatile("" ::: "memory"); }
    }
};
__device__ __forceinline__ float silu_f(float x) { return x * __builtin_amdgcn_rcpf(1.0f + __builtin_amdgcn_exp2f(-x * LOG2E)); }
struct EpiGU {
    static constexpr bool PERM = true;
    bf16_t* H;
    __device__ __forceinline__ void operator()(AccRef acc, const Unit& u, int wr, int wc, int fr, int fq) const { run<false>(acc, u, wr, wc, fr, fq, 0, 0); }
    template <bool SL> __device__ __forceinline__ void run(AccRef acc, const Unit& u, int wr, int wc, int fr, int fq, int sai, int sm) const {
        const int row0 = u.pm * 256 + wr * 64 + fr, col0 = u.pn * 128 + wc * 32 + 8 * fq;
#pragma unroll
        for (int ai = 0; ai < (SL ? 1 : 2); ++ai)
#pragma unroll
            for (int m = 0; m < (SL ? 1 : 4); ++m) { bf16_t* rowp = H + (size_t)(row0 + (SL ? sai : ai) * 128 + (SL ? sm : m) * 16) * FF + col0;
                f32x4 h0, h1;
#pragma unroll
                for (int j = 0; j < 4; ++j) { h0[j] = silu_f(acc[ai][0][m][0][j]) * acc[ai][1][m][0][j]; h1[j] = silu_f(acc[ai][0][m][1][j]) * acc[ai][1][m][1][j]; }
                u32x4 w; w.x = cvtpk(h0[0], h0[1]); w.y = cvtpk(h0[2], h0[3]); w.z = cvtpk(h1[0], h1[1]); w.w = cvtpk(h1[2], h1[3]);
                *(u32x4*)rowp = w; }
    }
};
struct EpiIn1 {
    static constexpr bool PERM = false;
    bf16_t* CQ; bf16_t* CKV; bf16_t* KR; float* ssq_q; float* ssq_kv; const f32x2* rope; unsigned* krmax2;
    __device__ __forceinline__ void operator()(AccRef acc, const Unit& u, int wr, int wc, int fr, int fq) const { run<false>(acc, u, wr, wc, fr, fq, 0, 0); }
    template <bool SL> __device__ __forceinline__ void run(AccRef acc, const Unit& u, int wr, int wc, int fr, int fq, int sai, int sm) const {
        const int row0 = u.pm * 256 + wr * 64 + fr;
        if (u.pn < 3) {
            bf16_t* base = (u.pn < 2) ? (CQ + u.pn * 256) : CKV; const int ld = (u.pn < 2) ? 512 : 256; float* ssq = (u.pn < 2) ? ssq_q : ssq_kv;
#pragma unroll
            for (int ai = 0; ai < (SL ? 1 : 2); ++ai)
#pragma unroll
                for (int m = 0; m < (SL ? 1 : 4); ++m) { const int r = row0 + (SL ? sai : ai) * 128 + (SL ? sm : m) * 16; bf16_t* rowp = base + (size_t)r * ld + wc * 32 + 4 * fq; float s = 0.f;
#pragma unroll
                    for (int bj = 0; bj < 2; ++bj)
#pragma unroll
                        for (int n = 0; n < 2; ++n) { const f32x4 x = acc[ai][bj][m][n]; s += (x[0] * x[0] + x[1] * x[1]) + (x[2] * x[2] + x[3] * x[3]); st_bf4(rowp + bj * 128 + n * 16, x); }
                    s += __shfl_xor(s, 16); s += __shfl_xor(s, 32);
                    if (fq == 0) atomicAdd(ssq + r, s); }
        } else if (wc < 2) {
            const bool dorope = u.pm < NLAT / 256; float kmx = 0.f;
#pragma unroll
            for (int ai = 0; ai < (SL ? 1 : 2); ++ai)
#pragma unroll
                for (int m = 0; m < (SL ? 1 : 4); ++m) { const int r = row0 + (SL ? sai : ai) * 128 + (SL ? sm : m) * 16; const int t = r & (SEQ - 1), ang = dorope ? ((wc & 1) ? (t & 63) : (t >> 6)) : 0;
                    f32x4 u1 = acc[ai][0][m][0], u2 = acc[ai][0][m][1];
                    rope4(u1, u2, rope, ang, 4 * fq);
                    { float s = ((u1[0] * u1[0] + u1[1] * u1[1]) + (u1[2] * u1[2] + u1[3] * u1[3])) + ((u2[0] * u2[0] + u2[1] * u2[1]) + (u2[2] * u2[2] + u2[3] * u2[3]));
                      s += __shfl_xor(s, 16); s += __shfl_xor(s, 32); kmx = fmaxf(kmx, s); }
                    bf16_t* rowp = KR + (size_t)r * 64 + wc * 32 + 4 * fq; st_bf4(rowp, u1); st_bf4(rowp + 16, u2); }
            { const int b = u.pm < NLAT / 256 ? (u.pm >> 6) : (u.pm - NLAT / 256);
#pragma unroll
              for (int o = 1; o < 16; o <<= 1) kmx = fmaxf(kmx, __shfl_xor(kmx, o));
              if (fr == 0 && fq == 0) atomicMax(krmax2 + b * 2 + wc, __float_as_uint(kmx)); }
        }
    }
};
struct EpiUQ {
    static constexpr bool PERM = false;
    bf16_t* Q1; const float* ssq_q; const f32x2* rope;
    __device__ __forceinline__ void operator()(AccRef acc, const Unit& u, int wr, int wc, int fr, int fq) const { run<false>(acc, u, wr, wc, fr, fq, 0, 0); }
    template <bool SL> __device__ __forceinline__ void run(AccRef acc, const Unit& u, int wr, int wc, int fr, int fq, int sai, int sm) const {
        const int row0 = u.pm * 256 + wr * 64 + fr;
#pragma unroll
        for (int ai = 0; ai < (SL ? 1 : 2); ++ai)
#pragma unroll
            for (int m = 0; m < (SL ? 1 : 4); ++m) { const int r = row0 + (SL ? sai : ai) * 128 + (SL ? sm : m) * 16; const int t = r & (SEQ - 1), ang = (wc & 1) ? (t & 63) : (t >> 6);
                const float rs = QSC1 / sqrtf(ssq_q[r] * (1.0f / 512.0f) + EPS);
                bf16_t* rowp = Q1 + (size_t)r * 1536 + u.pn * 256 + wc * 32 + 4 * fq;
#pragma unroll
                for (int bj = 0; bj < 2; ++bj) { f32x4 u1 = acc[ai][bj][m][0], u2 = acc[ai][bj][m][1];
                    const int b64 = 4 * u.pn + 2 * bj + (wc >> 1);
                    rope4(u1, u2, rope, (b64 % 3 == 2) ? ang : 0, 4 * fq);
                    st_bf4(rowp + bj * 128, u1 * rs); st_bf4(rowp + bj * 128 + 16, u2 * rs); } if (m == 3) asm volatile("" ::: "memory"); }
    }
};
struct EpiUKV {
    static constexpr bool PERM = true;
    bf16_t* KV1; const float* ssq_kv; unsigned* knmax2;
    bf16_t* VT1;
    LAS unsigned char* scr;
    __device__ __forceinline__ void operator()(AccRef acc, const Unit& u, int wr, int wc, int fr, int fq) const { run<false>(acc, u, wr, wc, fr, fq, 0, 0); }
    template <bool SL> __device__ __forceinline__ void run(AccRef acc, const Unit& u, int wr, int wc, int fr, int fq, int sai, int sm) const {
        const int row0 = u.pm * 256 + wr * 64 + fr, col0 = u.pn * 256 + wc * 32 + 8 * fq; float kmx = 0.f;
#pragma unroll
        for (int ai = 0; ai < (SL ? 1 : 2); ++ai)
#pragma unroll
            for (int m = 0; m < (SL ? 1 : 4); ++m) { const int r = row0 + (SL ? sai : ai) * 128 + (SL ? sm : m) * 16; const float rs = 1.0f / sqrtf(ssq_kv[r] * (1.0f / 256.0f) + EPS);
                bf16_t* rowp = KV1 + (size_t)r * 2048 + col0;
#pragma unroll
                for (int bj = 0; bj < 2; ++bj) { const f32x4 v0 = acc[ai][bj][m][0] * rs, v1 = acc[ai][bj][m][1] * rs;
                    if (bj == 0) { float s = ((v0[0] * v0[0] + v0[1] * v0[1]) + (v0[2] * v0[2] + v0[3] * v0[3])) + ((v1[0] * v1[0] + v1[1] * v1[1]) + (v1[2] * v1[2] + v1[3] * v1[3]));
                        s += __shfl_xor(s, 16); s += __shfl_xor(s, 32); kmx = fmaxf(kmx, s); }
                    if (bj == 0) { u32x4 w; w.x = cvtpk(v0[0], v0[1]); w.y = cvtpk(v0[2], v0[3]); w.z = cvtpk(v1[0], v1[1]); w.w = cvtpk(v1[2], v1[3]);
                        *(u32x4*)rowp = w; }
                    else vt_block(scr + (SL ? wr * 4 + sm : wr * 4 + wc) * 1024, VT1 + (size_t)(u.pn * 128 + wc * 32) * NROW + (r - fr), v0, v1, 8 * fq, 8 * fq + 4, fq * 16 + fr); } asm volatile("" ::: "memory"); }
        { const int b = u.pm < NLAT / 256 ? (u.pm >> 6) : (u.pm - NLAT / 256);
#pragma unroll
          for (int o = 1; o < 16; o <<= 1) kmx = fmaxf(kmx, __shfl_xor(kmx, o));
          if (fr == 0 && fq == 0) atomicMax(knmax2 + (b * 8 + u.pn) * 4 + wc, __float_as_uint(kmx)); }
    }
};
struct EpiMoeDown {
    static constexpr bool PERM = true;
    const bf16_t* src; bf16_t* dst; const float* g2;
    const int* idx; const float* wgt;
    const volatile LAS int* pb; const volatile LAS int* cnt;
    __device__ __forceinline__ void operator()(AccRef acc, const Unit& u, int wr, int wc, int fr, int fq) const { run<false>(acc, u, wr, wc, fr, fq, 0, 0); }
    template <bool SL> __device__ __forceinline__ void run(AccRef acc, const Unit& u, int wr, int wc, int fr, int fq, int sai, int sm) const {
        int e = 0;
#pragma unroll
        for (int k = 1; k < 8; ++k) e += (u.pm >= pb[k]) ? 1 : 0;
        const int lp = u.pm - pb[e], n_e = cnt[e];
        const int col0 = u.pn * 256 + wc * 32 + 8 * fq;
        int tok[8]; float wv[8];
#pragma unroll
        for (int g = 0; g < (SL ? 1 : 8); ++g) { const int pos = lp * 256 + (SL ? sai : (g >> 2)) * 128 + wr * 64 + (SL ? sm : (g & 3)) * 16 + fr; const bool ok = pos < n_e;
            tok[g] = ok ? idx[e * NLAT + pos] : -1; wv[g] = ok ? wgt[e * NLAT + pos] : 0.f; }
#pragma unroll
        for (int ai = 0; ai < (SL ? 1 : 2); ++ai)
#pragma unroll
            for (int m = 0; m < (SL ? 1 : 4); ++m) { const int t = tok[ai * 4 + m];
                if (t >= 0) { const float w = wv[ai * 4 + m]; const bf16_t* ip = src + (size_t)t * D + col0; bf16_t* op = dst + (size_t)t * D + col0; const float* gp = g2 + (t >> 14) * NMOD + col0;
#pragma unroll
                    for (int bj = 0; bj < 2; ++bj) { const u32x4 x = *(const u32x4*)(ip + bj * 128); const f32x4 ga = *(const f32x4*)(gp + bj * 128), gb = *(const f32x4*)(gp + bj * 128 + 4);
                        const f32x4 r0 = bf4_f(x.x, x.y) + ga * w * acc[ai][bj][m][0], r1 = bf4_f(x.z, x.w) + gb * w * acc[ai][bj][m][1];
                        u32x4 o; o.x = cvtpk(r0[0], r0[1]); o.y = cvtpk(r0[2], r0[3]); o.z = cvtpk(r1[0], r1[1]); o.w = cvtpk(r1[2], r1[3]);
                        *(u32x4*)(op + bj * 128) = o; } } if (m & 1) asm volatile("" ::: "memory"); }
    }
};
}
namespace att {
constexpr int KVBLK = 64;
constexpr float THRL = 11.5416f;
constexpr int VROW = 144, SHM_V = 128 * VROW;
template <int MODE> struct Cfg;
#ifndef ATT0_LSUM
#define ATT0_LSUM 0
#endif
constexpr int KROW_N = 272, KROW_R = 144, KIMG_N = 64 * KROW_N  , KIMG_R = 64 * KROW_R  ;
template <> struct Cfg<0> { static constexpr bool LSUM = ATT0_LSUM; static constexpr int NQ = 4, NQR = 4, SHM_K = KIMG_N, KRING = 3, PF = 2  ; };
#ifndef ATT1_NQR
#define ATT1_NQR 6
#endif
template <> struct Cfg<1> { static constexpr int NQ = 12, NQR = ATT1_NQR  , SHM_K = KIMG_N + KIMG_R, KRING = 2, PF = 2; static constexpr bool LSUM = false; };
#define SBAR() __builtin_amdgcn_sched_barrier(0)
#ifndef SGB_VALU
#define SGB_VALU 4
#endif
#define SGB_PIPE() do { _Pragma("unroll") for (int _g = 0; _g < 24; ++_g) { __builtin_amdgcn_sched_group_barrier(0x8, 1, 0); __builtin_amdgcn_sched_group_barrier(0x402, SGB_VALU, 0); __builtin_amdgcn_sched_group_barrier(0x100, 2, 0); } } while (0)
__device__ __forceinline__ int crow(int r, int hi) { return (r & 3) + 8 * (r >> 2) + 4 * hi; }
template <int VAR = 0, bool LSUM = false> __device__ __forceinline__ void expA(f32x16& p0, float& l_reg) {
#ifdef ATT_PRIO_EXP
    __builtin_amdgcn_s_setprio(1);
#endif
    if constexpr (VAR != 1) {
#pragma unroll
    for (int r = 0; r < 16; ++r) p0[r] = __builtin_amdgcn_exp2f(p0[r]); }
    if constexpr (!LSUM) { float ps = 0;
#pragma unroll
    for (int r = 0; r < 16; ++r) ps += p0[r];
    l_reg += ps; }
#ifdef ATT_PRIO_EXP
    __builtin_amdgcn_s_setprio(0);
#endif
}
template <int MODE> struct QkFrag { bf16x8 b0, b1, q; };
template <int MODE> __device__ __forceinline__ void qk_load(QkFrag<MODE>& f, int d0, const char* Ks, const bf16x8* qr, const char* qrl, int kn, int kr) {
    if (MODE == 0 || d0 < 8) { f.b0 = *reinterpret_cast<const bf16x8*>(Ks + kn + d0 * 32); f.b1 = *reinterpret_cast<const bf16x8*>(Ks + kn + 32 * KROW_N + d0 * 32); }
    else { f.b0 = *reinterpret_cast<const bf16x8*>(Ks + KIMG_N + kr + (d0 - 8) * 32); f.b1 = *reinterpret_cast<const bf16x8*>(Ks + KIMG_N + kr + 32 * KROW_R + (d0 - 8) * 32); }
    if constexpr (MODE == 1) { if (d0 >= Cfg<1>::NQR) f.q = *reinterpret_cast<const bf16x8*>(qrl + (d0 - Cfg<1>::NQR) * 1024); else f.q = qr[d0]; } else f.q = qr[d0];
}
template <int MODE> __device__ __forceinline__ void qk_pre(QkFrag<MODE>* f, const char* Ks, const bf16x8* qr, const char* qrl, int kn, int kr) {
#pragma unroll
    for (int d0 = 0; d0 < Cfg<MODE>::PF; ++d0) qk_load<MODE>(f[d0], d0, Ks, qr, qrl, kn, kr);
}
template <int MODE> __device__ __forceinline__ void qk_run(f32x16& p0, f32x16& p1, const f32x16& cm, QkFrag<MODE>* f, const char* Ks, const bf16x8* qr, const char* qrl, int kn, int kr) {
    constexpr int NQ = Cfg<MODE>::NQ, PF = Cfg<MODE>::PF;
#pragma unroll
    for (int d0 = 0; d0 < NQ; ++d0) {
        if (d0 + PF < NQ) qk_load<MODE>(f[d0 + PF], d0 + PF, Ks, qr, qrl, kn, kr);
        __builtin_amdgcn_sched_barrier(0x406);
        if (d0 == 0) { p0 = __builtin_amdgcn_mfma_f32_32x32x16_bf16(f[0].b0, f[0].q, cm, 0, 0, 0); p1 = __builtin_amdgcn_mfma_f32_32x32x16_bf16(f[0].b1, f[0].q, cm, 0, 0, 0); }
        else { p0 = __builtin_amdgcn_mfma_f32_32x32x16_bf16(f[d0].b0, f[d0].q, p0, 0, 0, 0); p1 = __builtin_amdgcn_mfma_f32_32x32x16_bf16(f[d0].b1, f[d0].q, p1, 0, 0, 0); }
        __builtin_amdgcn_sched_barrier(0x406);
    }
}
template <int MODE> __device__ __forceinline__ void qkt(f32x16& p0, f32x16& p1, const f32x16& cm, const char* Ks, const bf16x8* qr, const char* qrl, int kn, int kr) {
    QkFrag<MODE> f[Cfg<MODE>::NQ]; qk_pre<MODE>(f, Ks, qr, qrl, kn, kr); qk_run<MODE>(p0, p1, cm, f, Ks, qr, qrl, kn, kr);
}
__device__ __forceinline__ int v_st(int k, int c) { const int kk = (k & ~0xC) | ((k & 4) << 1) | ((k & 8) >> 1); return ((kk >> 3) * 4 + (c >> 5)) * 512 + ((kk & 7) * 32 + (c & 31)) * 2; }
__device__ __forceinline__ int v_rd_base(int lane) { return ((lane & 3) << 3) | (((lane >> 2) & 3) << 6) | (((lane >> 4) & 1) << 5) | (((lane >> 5) & 1) << 8); }
constexpr int v_rd_off(int d0, int ks, int half) { return d0 * 512 + ks * 4096 + half * 2048; }
template <int OFF> __device__ __forceinline__ s16x4 tr_read(int vb) {
    s16x4 r; asm volatile("ds_read_b64_tr_b16 %0, %1 offset:%2" : "=&v"(r) : "v"(vb), "i"(OFF) : "memory"); return r;
}
template <int KS, int VAR = 0, bool LSUM = false> __device__ __forceinline__ void pv_ks(f32x16* o, const char* vp, const f32x16& p) {
    static_assert(!LSUM, "row sums by MFMA are not available in the transposed form");
    constexpr int B = 8 * (KS & 1);
    const bf16x8 v0 = *reinterpret_cast<const bf16x8*>(vp + 0 * 32 * VROW + KS * 32), v1 = *reinterpret_cast<const bf16x8*>(vp + 1 * 32 * VROW + KS * 32);
    const bf16x8 v2 = *reinterpret_cast<const bf16x8*>(vp + 2 * 32 * VROW + KS * 32), v3 = *reinterpret_cast<const bf16x8*>(vp + 3 * 32 * VROW + KS * 32);
    bf16x8 pb;
    { u32x4 w = {cvtpk(p[B + 0], p[B + 1]), cvtpk(p[B + 2], p[B + 3]), cvtpk(p[B + 4], p[B + 5]), cvtpk(p[B + 6], p[B + 7])}; pb = *reinterpret_cast<bf16x8*>(&w); }
    if constexpr (VAR == 6) { asm volatile("" :: "v"(pb), "v"(v0), "v"(v1), "v"(v2), "v"(v3)); } else {
    o[0] = __builtin_amdgcn_mfma_f32_32x32x16_bf16(v0, pb, o[0], 0, 0, 0);
    o[1] = __builtin_amdgcn_mfma_f32_32x32x16_bf16(v1, pb, o[1], 0, 0, 0);
    o[2] = __builtin_amdgcn_mfma_f32_32x32x16_bf16(v2, pb, o[2], 0, 0, 0);
    o[3] = __builtin_amdgcn_mfma_f32_32x32x16_bf16(v3, pb, o[3], 0, 0, 0); }
}
template <int VAR = 0, bool LSUM = false> __device__ __forceinline__ void pv_all(f32x16* o, const char* vp, const f32x16& p0, const f32x16& p1) {
    pv_ks<0, VAR, LSUM>(o, vp, p0); pv_ks<1, VAR, LSUM>(o, vp, p0); pv_ks<2, VAR, LSUM>(o, vp, p1); pv_ks<3, VAR, LSUM>(o, vp, p1);
}

template <int VAR = 0> __device__ __forceinline__ void pv_all_pre(f32x16* o, const char* vp, const f32x16& p0, const f32x16& p1, const bf16x8 (&vf)[4]) {
    bf16x8 pb;
    { u32x4 w = {cvtpk(p0[0], p0[1]), cvtpk(p0[2], p0[3]), cvtpk(p0[4], p0[5]), cvtpk(p0[6], p0[7])}; pb = *reinterpret_cast<bf16x8*>(&w); }
#pragma unroll
    for (int d = 0; d < 4; ++d) o[d] = __builtin_amdgcn_mfma_f32_32x32x16_bf16(vf[d], pb, o[d], 0, 0, 0);
    pv_ks<1, VAR, false>(o, vp, p0); pv_ks<2, VAR, false>(o, vp, p1); pv_ks<3, VAR, false>(o, vp, p1);
}
#define ATT_VPRE(vf, vp) do { _Pragma("unroll") for (int _d = 0; _d < 4; ++_d) (vf)[_d] = *reinterpret_cast<const bf16x8*>((vp) + _d * 32 * VROW); } while (0)
template <int MODE, int VAR = 0>
__device__ __forceinline__ void attn_unit(const bf16_t* __restrict__ Qw, const bf16_t* __restrict__ Kg, const bf16_t* __restrict__ Vg, const bf16_t* __restrict__ KRg,
                                          int lat0, int nlt, int ctx0, int NT, bf16_t* __restrict__ Od, int orow0, float lam, const float* __restrict__ kb2, const float* __restrict__ kb2r,
                                          char* lds, LAS unsigned char* ldsl) {
    using C = Cfg<MODE>; constexpr int NQ = C::NQ, SHM_K = C::SHM_K;
    const int tid = opaque_tid(), wid = tid >> 6, lane = tid & 63, r32 = lane & 31, hi = lane >> 5;
    const int wu = __builtin_amdgcn_readfirstlane(wid);
    constexpr int VRING = C::KRING;
    char* V_lds = lds; char* K_lds = lds + VRING * SHM_V;
    constexpr int KRING = C::KRING;
    float* ws = (float*)(lds + VRING * SHM_V + KRING * SHM_K) + wid * 64; float* li_l = ws;
    float l_reg = 0; f32x16 o[4] = {}; bf16x8 qr[C::NQR];
    char* qrl = lds + VRING * SHM_V + KRING * SHM_K + 2048 + (wid * (NQ - C::NQR) * 64 + lane) * 16;
    float mrow = 0.f;
#pragma unroll
    for (int blk = 0; blk < NQ / 2; ++blk) { float s2 = 0.f;
#pragma unroll
        for (int dd = 0; dd < 2; ++dd) { const int d0 = 2 * blk + dd; const bf16x8 q = *reinterpret_cast<const bf16x8*>(Qw + d0 * 16);
#pragma unroll
            for (int j = 0; j < 8; ++j) { const float x = __uint_as_float(((unsigned)(unsigned short)q[j]) << 16); s2 += x * x; }
            if constexpr (MODE == 1) { if (d0 >= C::NQR) *reinterpret_cast<bf16x8*>(qrl + (d0 - C::NQR) * 1024) = q; else qr[d0] = q; } else qr[d0] = q; }
        s2 += __shfl_xor(s2, 32);
        float k2;
        if constexpr (MODE == 0) k2 = kb2[(wid >> 2) * 2 + blk]; else k2 = (blk < 4) ? kb2[blk] : kb2r[blk - 4];
        mrow += sqrtf(s2 * k2); }
    mrow = mrow * 1.01f + 1e-3f;
    f32x16 cm;
#pragma unroll
    for (int r = 0; r < 16; ++r) cm[r] = -mrow;
    const int kn = r32 * KROW_N + ((MODE == 0) ? (wid >> 2) * 128 : 0) + hi * 16, kr = r32 * KROW_R + hi * 16;
    const char* vp0 = V_lds + r32 * VROW + hi * 16;
    constexpr int KSTR = (MODE == 0) ? 768 : 2048;
    unsigned vsrc[3], ksrc[3], rsrc[2] = {0u, 0u};
    constexpr int KX = 1, RX = 2, VX0 = (MODE == 1) ? 3 : 2, VX1 = (MODE == 1) ? 4 : 3;
#pragma unroll
    for (int i = 0; i < 3; ++i) { const int pc = (i < 2) ? wid + 8 * i : 16 + (wid == VX1 ? 1 : 0); const int L = 1024 * pc + 16 * lane, col = (L / VROW) & 127, x = L - (L / VROW) * VROW; vsrc[i] = (unsigned)col * (unsigned)(NROW * 2) + (unsigned)(x < 128 ? x : 0); }
#pragma unroll
    for (int i = 0; i < 3; ++i) { const int pc = (i < 2) ? wid + 8 * i : 16; const int L = 1024 * pc + 16 * lane, row = (L / KROW_N) & 63, x = L - (L / KROW_N) * KROW_N; ksrc[i] = (unsigned)(row * KSTR) * 2u + (unsigned)(x < 256 ? x : 0); }
    if constexpr (MODE == 1) {
#pragma unroll
        for (int i = 0; i < 2; ++i) { const int pc = (i < 1) ? wid : 8; const int L = 1024 * pc + 16 * lane, row = (L / KROW_R) & 63, x = L - (L / KROW_R) * KROW_R; rsrc[i] = (unsigned)(row * 64) * 2u + (unsigned)(x < 128 ? x : 0); } }
    const unsigned vxo = (wu == VX1) ? 1024u : 0u;
    const unsigned pw = 1024u * (unsigned)wu;
#define TROW(j) ((j) < nlt ? lat0 + (j) * KVBLK : ctx0 + ((j) - nlt) * KVBLK)
#define DMA16(gp, loff) if constexpr (VAR != 3) __builtin_amdgcn_global_load_lds((const unsigned*)(gp), (LAS unsigned*)(ldsl + (loff)), 16, 0, 0)
#define LOADK(j, koff) do { const size_t _r = (size_t)TROW(j); const char* _kb = (const char*)(Kg + _r * KSTR); const unsigned _kl = VRING * SHM_V + (unsigned)(koff); \
    DMA16(_kb + ksrc[0], _kl + pw); DMA16(_kb + ksrc[1], _kl + 8192 + pw); if (wu == KX) DMA16(_kb + ksrc[2], _kl + 16384); \
    if constexpr (MODE == 1) { const char* _rb = (const char*)(KRg + _r * 64); DMA16(_rb + rsrc[0], _kl + KIMG_N + pw); if (wu == RX) DMA16(_rb + rsrc[1], _kl + KIMG_N + 8192); } } while (0)
#define LOADV(j, voff) do { const char* _vb = (const char*)Vg + (size_t)TROW(j) * 2; \
    DMA16(_vb + vsrc[0], (unsigned)(voff) + pw); DMA16(_vb + vsrc[1], (unsigned)(voff) + 8192 + pw); if (wu == VX0 || wu == VX1) DMA16(_vb + vsrc[2], (unsigned)(voff) + 16384 + vxo); } while (0)
#define SYNC() do { asm volatile("s_waitcnt vmcnt(0) lgkmcnt(0)" ::: "memory"); if constexpr (VAR != 2) __builtin_amdgcn_s_barrier(); asm volatile("" ::: "memory"); } while (0)
#define SYNCK() do { if constexpr (KRING == 3) { if constexpr (MODE == 0) asm volatile("s_waitcnt vmcnt(4) lgkmcnt(0)" ::: "memory"); else asm volatile("s_waitcnt vmcnt(5) lgkmcnt(0)" ::: "memory"); } \
    else asm volatile("s_waitcnt vmcnt(0) lgkmcnt(0)" ::: "memory"); if constexpr (VAR != 2) __builtin_amdgcn_s_barrier(); asm volatile("" ::: "memory"); } while (0)
    f32x16 pA0, pA1, pB0, pB1;
    if constexpr (KRING == 2) {
    LOADK(0, 0); LOADV(0, 0); LOADK(1, SHM_K); SYNC();
    if constexpr (VAR != 5) qkt<MODE>(pA0, pA1, cm, K_lds, qr, qrl, kn, kr); expA<VAR, C::LSUM>(pA0, l_reg); SYNC();
    for (int j = 0; j + 2 < NT; j += 2) {
        LOADK(j + 2, 0); LOADV(j + 1, SHM_V);
        { QkFrag<MODE> kf[NQ]; SBAR(); if constexpr (VAR != 5) qk_pre<MODE>(kf, K_lds + SHM_K, qr, qrl, kn, kr); SBAR(); expA<VAR, C::LSUM>(pA1, l_reg); if constexpr (VAR != 5) qk_run<MODE>(pB0, pB1, cm, kf, K_lds + SHM_K, qr, qrl, kn, kr); SBAR(); }
        if constexpr (VAR != 4) pv_all<VAR, C::LSUM>(o, vp0, pA0, pA1); expA<VAR, C::LSUM>(pB0, l_reg);
        SYNC();
        LOADK(j + 3, SHM_K); LOADV(j + 2, 0);
        { QkFrag<MODE> kf[NQ]; SBAR(); if constexpr (VAR != 5) qk_pre<MODE>(kf, K_lds, qr, qrl, kn, kr); SBAR(); expA<VAR, C::LSUM>(pB1, l_reg); if constexpr (VAR != 5) qk_run<MODE>(pA0, pA1, cm, kf, K_lds, qr, qrl, kn, kr); SBAR(); }
        if constexpr (VAR != 4) pv_all<VAR, C::LSUM>(o, vp0 + SHM_V, pB0, pB1); expA<VAR, C::LSUM>(pA0, l_reg);
        SYNC();
    }
    LOADV(NT - 1, SHM_V);
    { QkFrag<MODE> kf[NQ]; SBAR(); if constexpr (VAR != 5) qk_pre<MODE>(kf, K_lds + SHM_K, qr, qrl, kn, kr); SBAR(); expA<VAR, C::LSUM>(pA1, l_reg); if constexpr (VAR != 5) qk_run<MODE>(pB0, pB1, cm, kf, K_lds + SHM_K, qr, qrl, kn, kr); SBAR(); }
    if constexpr (VAR != 4) pv_all<VAR, C::LSUM>(o, vp0, pA0, pA1); expA<VAR, C::LSUM>(pB0, l_reg);
    SYNC();
    expA<VAR, C::LSUM>(pB1, l_reg);
    if constexpr (VAR != 4) pv_all<VAR, C::LSUM>(o, vp0 + SHM_V, pB0, pB1);
    } else {
    LOADK(0, 0); LOADV(0, 0); LOADK(1, SHM_K); LOADV(1, SHM_V); LOADK(2, 2 * SHM_K); SYNC();
    if constexpr (VAR != 5) qkt<MODE>(pA0, pA1, cm, K_lds, qr, qrl, kn, kr); expA<VAR, C::LSUM>(pA0, l_reg); SYNC();
    int k0 = 0, k1 = SHM_K, k2 = 2 * SHM_K;
    int v0 = 0, v1 = SHM_V, v2 = 2 * SHM_V;
    for (int j = 0; j + 2 < NT; j += 2) {
        LOADV(j + 2, v2); LOADK((j + 3 < NT) ? j + 3 : NT - 1, k0);
        { QkFrag<MODE> kf[NQ]; bf16x8 vf[4]; SBAR(); if constexpr (VAR != 5) qk_pre<MODE>(kf, K_lds + k1, qr, qrl, kn, kr); ATT_VPRE(vf, vp0 + v0); SBAR(); expA<VAR, C::LSUM>(pA1, l_reg); if constexpr (VAR != 5) qk_run<MODE>(pB0, pB1, cm, kf, K_lds + k1, qr, qrl, kn, kr); SBAR();
          if constexpr (VAR != 4) pv_all_pre<VAR>(o, vp0 + v0, pA0, pA1, vf); } expA<VAR, C::LSUM>(pB0, l_reg);
        SYNCK();
        LOADV((j + 3 < NT) ? j + 3 : NT - 1, v0); LOADK((j + 4 < NT) ? j + 4 : NT - 1, k1);
        { QkFrag<MODE> kf[NQ]; bf16x8 vf[4]; SBAR(); if constexpr (VAR != 5) qk_pre<MODE>(kf, K_lds + k2, qr, qrl, kn, kr); ATT_VPRE(vf, vp0 + v1); SBAR(); expA<VAR, C::LSUM>(pB1, l_reg); if constexpr (VAR != 5) qk_run<MODE>(pA0, pA1, cm, kf, K_lds + k2, qr, qrl, kn, kr); SBAR();
          if constexpr (VAR != 4) pv_all_pre<VAR>(o, vp0 + v1, pB0, pB1, vf); } expA<VAR, C::LSUM>(pA0, l_reg);
        SYNCK();
        { const int t = k0; k0 = k2; k2 = k1; k1 = t; }
        { const int t = v0; v0 = v2; v2 = v1; v1 = t; }
    }
    SYNC();
    { QkFrag<MODE> kf[NQ]; SBAR(); if constexpr (VAR != 5) qk_pre<MODE>(kf, K_lds + k1, qr, qrl, kn, kr); SBAR(); expA<VAR, C::LSUM>(pA1, l_reg); if constexpr (VAR != 5) qk_run<MODE>(pB0, pB1, cm, kf, K_lds + k1, qr, qrl, kn, kr); SBAR(); }
    if constexpr (VAR != 4) pv_all<VAR, C::LSUM>(o, vp0 + v0, pA0, pA1); expA<VAR, C::LSUM>(pB0, l_reg);
    expA<VAR, C::LSUM>(pB1, l_reg);
    if constexpr (VAR != 4) pv_all<VAR, C::LSUM>(o, vp0 + v1, pB0, pB1);
    }
    l_reg += __shfl_xor(l_reg, 32);
    static_assert(!C::LSUM, "");
    const float rl = __builtin_amdgcn_rcpf(l_reg);
#define ATT_STORE_ROW(SC) do { bf16_t* Ow = Od + (size_t)(orow0 + (wid & (MODE == 0 ? 3 : 7)) * 32 + r32) * D + 8 * hi; \
        _Pragma("unroll") for (int d0 = 0; d0 < 4; ++d0) \
            _Pragma("unroll") for (int m = 0; m < 2; ++m) { \
                unsigned a0 = cvtpk(o[d0][8 * m + 0] * (SC), o[d0][8 * m + 1] * (SC)), a1 = cvtpk(o[d0][8 * m + 2] * (SC), o[d0][8 * m + 3] * (SC)); \
                unsigned b0 = cvtpk(o[d0][8 * m + 4] * (SC), o[d0][8 * m + 5] * (SC)), b1 = cvtpk(o[d0][8 * m + 6] * (SC), o[d0][8 * m + 7] * (SC)); \
                auto r0 = __builtin_amdgcn_permlane32_swap(a0, b0, false, false); auto r1 = __builtin_amdgcn_permlane32_swap(a1, b1, false, false); \
                u32x4 w = {r0[0], r1[0], r0[1], r1[1]}; *reinterpret_cast<u32x4*>(Ow + d0 * 32 + m * 16) = w; } } while (0)
    if constexpr (MODE == 1) {
        ATT_STORE_ROW(rl);
        __syncthreads();
    } else {
        float* X = (float*)lds;
#pragma unroll
        for (int d0 = 0; d0 < 4; ++d0)
#pragma unroll
            for (int r = 0; r < 16; ++r) o[d0][r] *= rl;
        __syncthreads();
        if (wid >= 4) {
#pragma unroll
            for (int d0 = 0; d0 < 4; ++d0)
#pragma unroll
                for (int r = 0; r < 16; ++r) X[((wid - 4) * 64 + d0 * 16 + r) * 64 + lane] = o[d0][r];
        }
        __syncthreads();
        if (wid < 4) {
            float ss = 0.f;
#pragma unroll
            for (int d0 = 0; d0 < 4; ++d0)
#pragma unroll
                for (int r = 0; r < 16; ++r) { const float a = o[d0][r] - lam * X[(wid * 64 + d0 * 16 + r) * 64 + lane]; o[d0][r] = a; ss += a * a; }
            ss += __shfl_xor(ss, 32);
            const float rs = (1.0f - LAM_INIT0) / sqrtf(ss * (1.0f / 128.0f) + EPS);
            ATT_STORE_ROW(rs);
        }
        __syncthreads();
    }
#undef ATT_STORE_ROW
#undef TROW
#undef DMA16
#undef LOADK
#undef LOADV
#undef SYNC
#undef SYNCK
}
}
struct Args { const float* in[30]; float* out; unsigned char* ws; int ph_lo, ph_hi; };
enum { I_X = 0, I_C, I_CTX, I_CCTX, I_N1G, I_N2G, I_MODW, I_MODB, I_EWIN, I_POOLW, I_POOLS, I_LQ1, I_LK1, I_LQ2, I_LK2, I_EWOUT, I_FG, I_FU, I_FD,
       I_OWIN, I_QNG, I_KVNG, I_WUQ, I_WUKV, I_OWOUT, I_RTW, I_MG, I_MU, I_MD, I_FNG };

__device__ __forceinline__ void tr_load(const float* W, int N, int k0, int n0, const float* ksc, LAS float* scr, int lane) {
    float v[32];
#pragma unroll
    for (int i = 0; i < 32; ++i) v[i] = W[(size_t)(k0 + 2 * i + (lane >> 5)) * N + n0 + (lane & 31)];
    if (ksc) {
#pragma unroll
        for (int i = 0; i < 32; ++i) v[i] *= ksc[k0 + 2 * i + (lane >> 5)]; }
#pragma unroll
    for (int i = 0; i < 32; ++i) scr[(2 * i + (lane >> 5)) * 33 + (lane & 31)] = v[i];
    LDS_WAIT(); asm volatile("" ::: "memory");
}
__device__ __forceinline__ void tr_store(bf16_t* drow0, int ldk, int k0, LAS float* scr, int lane) {
    const int c = lane & 7;
#pragma unroll
    for (int j = 0; j < 4; ++j) { const int n = (lane >> 3) + 8 * j; const LAS float* s = scr + (8 * c) * 33 + n;
        u32x4 o; o.x = pk2(s[0 * 33], s[1 * 33]); o.y = pk2(s[2 * 33], s[3 * 33]); o.z = pk2(s[4 * 33], s[5 * 33]); o.w = pk2(s[6 * 33], s[7 * 33]);
        *(u32x4*)(drow0 + (size_t)n * ldk + k0 + 8 * c) = o; }
    LDS_WAIT(); asm volatile("" ::: "memory");
}
__device__ __forceinline__ void tr_item(const float* W, int N, int it, const float* ksc, bf16_t* dst, int ldk, int rowmode, LAS float* scr, int lane) {
    const int nblk = N / 32, kb = it / nblk, nb = it - kb * nblk, k0 = 64 * kb, n0 = 32 * nb;
    const int drow0 = rowmode == 0 ? n0 : (256 * (n0 >> 7) + (n0 & 127) + (rowmode == 2 ? 128 : 0));
    tr_load(W, N, k0, n0, ksc, scr, lane);
    tr_store(dst + (size_t)drow0 * ldk, ldk, k0, scr, lane);
}
__device__ __forceinline__ void tr_item_fold(const float* W, const float* pw, const float* ps, int it, bf16_t* dst, LAS float* scr, int lane) {
    const int g = it / 32, nb = it - g * 32, k0 = 64 * g, n0 = 32 * nb, n = lane & 31, half = lane >> 5;
    tr_load(W, D, k0, n0, nullptr, scr, lane);
    float acc[32];
#pragma unroll
    for (int i = 0; i < 32; ++i) acc[i] = 0.f;
    for (int e = 0; e < 64; ++e) { const float x = scr[e * 33 + n] * ps[k0 + e];
#pragma unroll
        for (int i = 0; i < 32; ++i) acc[i] += pw[(size_t)(k0 + 2 * i + half) * 64 + e] * x; }
    LDS_WAIT(); asm volatile("" ::: "memory");
#pragma unroll
    for (int i = 0; i < 32; ++i) scr[(2 * i + half) * 33 + n] = acc[i];
    LDS_WAIT(); asm volatile("" ::: "memory");
    tr_store(dst + (size_t)n0 * D, D, k0, scr, lane);
}

__device__ __forceinline__ void norm_mod_row(const float* __restrict__ hrow, const float* __restrict__ g, const float* __restrict__ sh, const float* __restrict__ sc, bf16_t* __restrict__ orow, int lane, f32x4 (&a)[4]) {
    const f32x4* xr = (const f32x4*)hrow + lane; float s = 0.f; f32x4 gv[4], sv[4], cv[4];
#pragma unroll
    for (int j = 0; j < 4; ++j) a[j] = xr[64 * j];
#pragma unroll
    for (int j = 0; j < 4; ++j) { gv[j] = ((const f32x4*)g)[64 * j + lane]; sv[j] = ((const f32x4*)sh)[64 * j + lane]; cv[j] = ((const f32x4*)sc)[64 * j + lane]; }
#pragma unroll
    for (int j = 0; j < 4; ++j) s += (a[j][0] * a[j][0] + a[j][1] * a[j][1]) + (a[j][2] * a[j][2] + a[j][3] * a[j][3]);
    const float r = 1.0f / sqrtf(wave_sum(s) * (1.0f / D) + EPS);
    u32x2* o8 = (u32x2*)orow + lane; u32x2 w[4];
#pragma unroll
    for (int j = 0; j < 4; ++j) { a[j] = (a[j] * r) * gv[j] * (1.0f + cv[j]) + sv[j]; w[j].x = cvtpk(a[j][0], a[j][1]); w[j].y = cvtpk(a[j][2], a[j][3]); }
#pragma unroll
    for (int j = 0; j < 4; ++j) o8[64 * j] = w[j];
}
template <bool BF, int NR> __device__ __forceinline__ void norm_rowsN(const char* __restrict__ h, const f32x4 (&gs)[4], const f32x4 (&sv)[4], bf16_t* __restrict__ o, int lane) {
    constexpr size_t RB = BF ? 2 * D : 4 * D;
    f32x4 a[NR][4]; float ss[NR];
    if constexpr (BF) { u32x2 raw[NR][4];
#pragma unroll
        for (int q = 0; q < NR; ++q)
#pragma unroll
            for (int j = 0; j < 4; ++j) raw[q][j] = ((const u32x2*)(h + q * RB) + lane)[64 * j];
#pragma unroll
        for (int q = 0; q < NR; ++q)
#pragma unroll
            for (int j = 0; j < 4; ++j) a[q][j] = epi::bf4_f(raw[q][j].x, raw[q][j].y); }
    else {
#pragma unroll
        for (int q = 0; q < NR; ++q)
#pragma unroll
            for (int j = 0; j < 4; ++j) a[q][j] = ((const f32x4*)(h + q * RB) + lane)[64 * j]; }
#pragma unroll
    for (int q = 0; q < NR; ++q) { float s = 0.f;
#pragma unroll
        for (int j = 0; j < 4; ++j) s += (a[q][j][0] * a[q][j][0] + a[q][j][1] * a[q][j][1]) + (a[q][j][2] * a[q][j][2] + a[q][j][3] * a[q][j][3]);
        ss[q] = s; }
#pragma unroll
    for (int x = 1; x < 64; x <<= 1)
#pragma unroll
        for (int q = 0; q < NR; ++q) ss[q] += __shfl_xor(ss[q], x);
#pragma unroll
    for (int q = 0; q < NR; ++q) { const float r = 1.0f / sqrtf(ss[q] * (1.0f / D) + EPS); u32x2* p = (u32x2*)(o + (size_t)q * D) + lane;
#pragma unroll
        for (int j = 0; j < 4; ++j) { const f32x4 y = (a[q][j] * r) * gs[j] + sv[j]; u32x2 w; w.x = cvtpk(y[0], y[1]); w.y = cvtpk(y[2], y[3]); p[64 * j] = w; } }
}
template <bool BF> __device__ __forceinline__ void norm_phase(const void* hl, const void* hc, const float* ng, const float* modl, int ch, bf16_t* A, int nrows, int gw, int ngw, int lane) {
    constexpr size_t RB = BF ? 2 * D : 4 * D;
    f32x4 gv[4], gs[4], sv[4];
#pragma unroll
    for (int j = 0; j < 4; ++j) gv[j] = ((const f32x4*)ng)[64 * j + lane];
    for (int r0 = gw * 16; r0 < NLAT; r0 += ngw * 16) {
        const float* mv = modl + (r0 >> 14) * NMOD;
#pragma unroll
        for (int j = 0; j < 4; ++j) { gs[j] = gv[j] * (((const f32x4*)(mv + (ch + 1) * D))[64 * j + lane] + 1.0f); sv[j] = ((const f32x4*)(mv + ch * D))[64 * j + lane]; }
        for (int q = 0; q < 16; q += 4) norm_rowsN<BF, 4>((const char*)hl + (size_t)(r0 + q) * RB, gs, sv, A + (size_t)(r0 + q) * D, lane);
    }
    if (nrows > NLAT && NLAT + gw < nrows) {
        const float* mv = modl + 2 * NMOD;
#pragma unroll
        for (int j = 0; j < 4; ++j) { gs[j] = gv[j] * (((const f32x4*)(mv + (ch + 1) * D))[64 * j + lane] + 1.0f); sv[j] = ((const f32x4*)(mv + ch * D))[64 * j + lane]; }
        for (int r = NLAT + gw; r < nrows; r += ngw) norm_rowsN<BF, 1>((const char*)hc + (size_t)(r - NLAT) * RB, gs, sv, A + (size_t)r * D, lane);
    }
}

__global__ void __launch_bounds__(NTHR, 2) fwd_kernel(Args args) {
    extern __shared__ __attribute__((aligned(16))) unsigned char lds[];
    LAS unsigned char* ldsl = (LAS unsigned char*)lds;
    volatile LAS unsigned* MISC = (volatile LAS unsigned*)(ldsl + MISC_OFF);
    const int wave = __builtin_amdgcn_readfirstlane(threadIdx.x >> 6);
    const int G = gridDim.x, bx = blockIdx.x, gw = bx * NW + wave, ngw = G * NW;
    unsigned* ctl0 = (unsigned*)(args.ws + WS_CTL);
    for (int u = threadIdx.x; u < (LDS_BYTES - MISC_OFF) / 4; u += NTHR) MISC[u] = 0u;
    __syncthreads();
    XcdBarrier bar = xcd_barrier_post(ctl0 + CW_BAR, MISC);
    const int lo = args.ph_lo, hi_ = args.ph_hi;
#define PHASE_PTRS unsigned char* ws = args.ws; asm volatile("" : "+s"(ws)); float* OUT = args.out; asm volatile("" : "+s"(OUT)); unsigned* ctl = (unsigned*)(ws + WS_CTL); float* modv = (float*)(ws + WS_TAB); f32x2* rope = (f32x2*)(ws + WS_TAB + TAB_ROPE); int* midx = (int*)(ws + WS_TAB + TAB_IDX); float* mwgt = (float*)(ws + WS_TAB + TAB_WGT); float* ssq_q = (float*)(ws + CTL_SSQQ); float* ssq_kv = (float*)(ws + CTL_SSQKV); unsigned* kmax2 = (unsigned*)(ws + 65536); unsigned* knmax2 = (unsigned*)(ws + 65536 + 1024); unsigned* krmax2 = (unsigned*)(ws + 65536 + 2048); bf16_t* HC = (bf16_t*)(ws + WS_HC); bf16_t* HS = (bf16_t*)(OUT + (size_t)NLAT * D / 2); (void)HS; bf16_t* Wb = (bf16_t*)(ws + WS_W); bf16_t* Abuf = (bf16_t*)(ws + WS_A); unsigned char* big = ws + WS_BIG; (void)ctl; (void)modv; (void)rope; (void)midx; (void)mwgt; (void)ssq_q; (void)ssq_kv; (void)kmax2; (void)knmax2; (void)krmax2; (void)HC; (void)Wb; (void)Abuf; (void)big; (void)OUT;
#define INP(i) ({ int _i = (i); asm volatile("" : "+s"(_i)); args.in[_i]; })
#ifndef ONLY_PHASE
#define ONLY_PHASE -1
#endif
#ifndef REPEAT_PHASE
#define REPEAT_PHASE -1
#endif
#define IN(k) ((ONLY_PHASE < 0 || ONLY_PHASE == (k)) && lo <= (k) && (k) < hi_)
#ifndef REPN
#define REPN 2
#endif
#define REP(k) for (int rep_ = 0; rep_ < ((REPEAT_PHASE == (k)) ? REPN : 1); ++rep_)
#define SEAM(k) do { if (IN(k) && IN((k) + 1)) xcd_barrier(bar); } while (0)

    constexpr int N_IN0 = 16 * 80, N_OUT0 = 16 * 32, N_G0 = 16 * 88, N_D0 = 44 * 32, N_IN1 = 16 * 26, N_Z1 = 192, N_UQ = 8 * 48, N_UKV = 4 * 64, N_OUT1 = 16 * 32;
    constexpr int NITEMS = N_IN0 + N_OUT0 + 2 * N_G0 + N_D0 + N_IN1 + N_Z1 + N_UQ + N_UKV + N_OUT1;
#define LAYER_WCONV(lo_, hi_i) do { LAS float* scr = (LAS float*)(ldsl + wave * 16384); \
        for (int it = (lo_) + gw; it < (hi_i); it += ngw) { \
            int r = it; \
            if (r < N_IN0) { tr_item(INP(I_EWIN), 2560, r, nullptr, Wb + W_IN0 / 2, D, 0, scr, lane); continue; } r -= N_IN0; \
            if (r < N_OUT0) { if (r < 128) tr_item_fold(INP(I_EWOUT), INP(I_POOLW), INP(I_POOLS), r, Wb + W_OUT0 / 2, scr, lane); \
                              else tr_item(INP(I_EWOUT), D, r, nullptr, Wb + W_OUT0 / 2, D, 0, scr, lane); continue; } r -= N_OUT0; \
            if (r < N_G0) { tr_item(INP(I_FG), FF, r, nullptr, Wb + W_GU0 / 2, D, 1, scr, lane); continue; } r -= N_G0; \
            if (r < N_G0) { tr_item(INP(I_FU), FF, r, nullptr, Wb + W_GU0 / 2, D, 2, scr, lane); continue; } r -= N_G0; \
            if (r < N_D0) { tr_item(INP(I_FD), D, r, nullptr, Wb + W_DN0 / 2, FF, 0, scr, lane); continue; } r -= N_D0; \
            if (r < N_IN1) { tr_item(INP(I_OWIN), 832, r, nullptr, Wb + W_IN1 / 2, D, 0, scr, lane); continue; } r -= N_IN1; \
            if (r < N_Z1) { u32x4* z = (u32x4*)(Wb + W_IN1 / 2 + (size_t)(832 + r) * D); z[lane] = (u32x4){0u, 0u, 0u, 0u}; z[64 + lane] = (u32x4){0u, 0u, 0u, 0u}; continue; } r -= N_Z1; \
            if (r < N_UQ) { tr_item(INP(I_WUQ), 1536, r, INP(I_QNG), Wb + W_UQ / 2, 512, 0, scr, lane); continue; } r -= N_UQ; \
            if (r < N_UKV) { tr_item(INP(I_WUKV), 2048, r, INP(I_KVNG), Wb + W_UKV / 2, 256, 0, scr, lane); continue; } r -= N_UKV; \
            tr_item(INP(I_OWOUT), D, r, nullptr, Wb + W_OUT1 / 2, D, 0, scr, lane); } } while (0)
    asm volatile("; ===PHASE 0");
    REP(0) if (IN(0)) { const int tid = opaque_tid(), lane = tid & 63; (void)tid; (void)lane; PHASE_PTRS
        if (bx < 192) {
            const int i = bx / 96, n = (bx % 96) * 64 + lane; const float* mw = INP(I_MODW) + (size_t)i * D * NMOD + n;
            const float* c0 = INP(I_C), *c1 = INP(I_C) + D, *c2 = INP(I_CCTX);
            LAS float* sil = (LAS float*)ldsl + 2048;
            for (int e = tid; e < 3 * D; e += NTHR) { const int v = e >> 10, k = e & (D - 1); const float x = (v == 0) ? c0[k] : (v == 1) ? c1[k] : c2[k]; sil[e] = x / (1.0f + expf(-x)); }
            __syncthreads();
            float a0 = 0.f, a1 = 0.f, a2 = 0.f;
            for (int kk = 0; kk < 128; kk += 16) { float w[16];
#pragma unroll
                for (int q = 0; q < 16; ++q) w[q] = mw[(size_t)(wave * 128 + kk + q) * NMOD];
#pragma unroll
                for (int q = 0; q < 16; ++q) { const int k = wave * 128 + kk + q; a0 += sil[k] * w[q]; a1 += sil[D + k] * w[q]; a2 += sil[2 * D + k] * w[q]; } }
            LAS float* red = (LAS float*)ldsl;
            red[(wave * 3 + 0) * 64 + lane] = a0; red[(wave * 3 + 1) * 64 + lane] = a1; red[(wave * 3 + 2) * 64 + lane] = a2;
            __syncthreads();
            if (wave < 3) { float s = INP(I_MODB)[i * NMOD + n];
#pragma unroll
                for (int w = 0; w < 8; ++w) s += red[(w * 3 + wave) * 64 + lane];
                modv[(i * 3 + wave) * NMOD + n] = s; }
            __syncthreads();
        } else if (bx == 200) {
            for (int e = tid; e < 4096; e += NTHR) { const int a = e >> 4, i = e & 15; const float inv = exp2f(-(float)i * (13.287712379549449f / 16.0f));
                double rev = (double)((float)a * inv) * 0.15915494309189535; rev -= rint(rev); const float fr = (float)rev;
                rope[e] = (f32x2){__builtin_amdgcn_cosf(fr), __builtin_amdgcn_sinf(fr)}; }
        }
        LAYER_WCONV(0, N_IN0);
    }
    SEAM(0);
    asm volatile("; ===PHASE 1");
    REP(1) if (IN(1)) { const int tid = opaque_tid(), lane = tid & 63; (void)tid; (void)lane; PHASE_PTRS norm_phase<false>(INP(I_X), INP(I_CTX), INP(I_N1G), modv, 0, Abuf, NROW, gw, ngw, lane); }
    SEAM(1);
    asm volatile("; ===PHASE 2");
    REP(2) if (IN(2)) { const int tid = opaque_tid(), lane = tid & 63; (void)tid; (void)lane; PHASE_PTRS
        pg8::Gemm g{Abuf, Wb + W_IN0 / 2, NROW, 2560, D, nullptr, 0}; pg8::StaticOrder S; S.init(NROW, 2560, G, bx);
        epi::EpiIn0 E{(float*)(big + B_P), (bf16_t*)(big + B_Q), (bf16_t*)(big + B_K), (bf16_t*)(big + B_V), rope, kmax2, ldsl + 144 * 1024};
        pg8::gemm_run<epi::EpiIn0, true, true>(ldsl, g, S, E);
    }
    SEAM(2);
    asm volatile("; ===PHASE 3");
    if (IN(3)) { const int tid = opaque_tid(), lane = tid & 63; (void)tid; (void)lane; PHASE_PTRS
        const bool conv_first3 = ((bx >> 3) & 1) == 0;
        if (conv_first3) { LAYER_WCONV(N_IN0, NITEMS); __syncthreads(); }
        const float* P = (const float*)(big + B_P); bf16_t* MIX = (bf16_t*)(big + B_MIX);
        for (int blk = gw; blk < NROW / 16; blk += ngw) {
            const int m0 = blk * 16;
            int sb, t0, L; if (m0 < NLAT) { sb = m0 & ~(SEQ - 1); t0 = m0 & (SEQ - 1); L = SEQ; } else { sb = NLAT + ((m0 - NLAT) & ~(CTX - 1)); t0 = (m0 - NLAT) & (CTX - 1); L = CTX; }
            f32x4 r[32];
#pragma unroll
            for (int j = 0; j < 32; ++j) { const int tt = t0 - 8 + j; const bool ok = (tt >= 0) && (tt < L);
                const f32x4 x = *(const f32x4*)(P + (size_t)(sb + (ok ? tt : t0)) * 256 + lane * 4); r[j] = ok ? x : (f32x4){0.f, 0.f, 0.f, 0.f}; }
            const int g = lane >> 4, half = 1 << g;
            f32x4 w1 = r[7] + r[8], w2 = w1 + (r[6] + r[9]), w4 = w2 + ((r[4] + r[5]) + (r[10] + r[11])), w8 = w4 + (((r[0] + r[1]) + (r[2] + r[3])) + ((r[12] + r[13]) + (r[14] + r[15])));
#pragma unroll
            for (int i = 0; i < 16; ++i) { const int t = t0 + i, tlo = max(t - half, 0), thi = min(t + half, L);
                const f32x4 s = (g == 0) ? w1 : (g == 1) ? w2 : (g == 2) ? w4 : w8;
                const float rc = 1.0f / (float)(thi - tlo);
                epi::st_bf4(MIX + (size_t)(m0 + i) * D + lane * 4, s * rc - r[i + 8]);
                if (i < 15) { w1 += r[i + 9] - r[i + 7]; w2 += r[i + 10] - r[i + 6]; w4 += r[i + 12] - r[i + 4]; w8 += r[i + 16] - r[i]; } }
        }
        float lam;
        { const float d1 = wave_sum(INP(I_LQ1)[lane] * INP(I_LK1)[lane]), d2 = wave_sum(INP(I_LQ2)[lane] * INP(I_LK2)[lane]); lam = expf(d1) - expf(d2) + LAM_INIT0; }
        const bf16_t* Qb = (const bf16_t*)(big + B_Q); const bf16_t* Kb = (const bf16_t*)(big + B_K); const bf16_t* Vb = (const bf16_t*)(big + B_V);
        const int r32 = lane & 31, hi = lane >> 5, map = wave >> 2, w4 = wave & 3;
        constexpr int NU_LAT = NB * 6 * (SEQ / 128), NU = NU_LAT + NB * 6 * (CTX / 128);
        const int vbx = (G == 256) ? ((bx & 7) * 32 + (bx >> 3)) : bx;
        for (int uu = vbx; uu < NU * ((REPEAT_PHASE == 3) ? 2 : 1); uu += G) { const int u = uu >= NU ? uu - NU : uu;
            int b, h, qrow0, lat0, nlt, ctx0, NT;
            if (u < NU_LAT) { const int qb = u & 127, bh = u >> 7; b = bh / 6; h = bh - b * 6; qrow0 = b * SEQ + qb * 128; lat0 = b * SEQ; nlt = SEQ / 64; ctx0 = NLAT + b * CTX; NT = nlt + CTX / 64; }
            else { const int v = u - NU_LAT, qb = v & 1, bh = v >> 1; b = bh / 6; h = bh - b * 6; qrow0 = NLAT + b * CTX + qb * 128; lat0 = 0; nlt = 0; ctx0 = NLAT + b * CTX; NT = CTX / 64; }
            const bf16_t* Qw = Qb + (size_t)(qrow0 + w4 * 32 + r32) * 768 + h * 128 + map * 64 + hi * 8;
            att::attn_unit<0>(Qw, Kb + h * 128, Vb + (size_t)h * 128 * NROW, nullptr, lat0, nlt, ctx0, NT, MIX + 256 + h * 128, qrow0, lam, (const float*)kmax2 + (b * 6 + h) * 4, nullptr, (char*)lds, ldsl);
        }
        if (!conv_first3) { __syncthreads(); LAYER_WCONV(N_IN0, NITEMS); }
#ifdef SHADOW_VAR
        for (int u = bx; u < NU; u += G) {
            int b, h, qrow0, lat0, nlt, ctx0, NT;
            if (u < NU_LAT) { const int qb = u & 127, bh = u >> 7; b = bh / 6; h = bh - b * 6; qrow0 = b * SEQ + qb * 128; lat0 = b * SEQ; nlt = SEQ / 64; ctx0 = NLAT + b * CTX; NT = nlt + CTX / 64; }
            else { const int v = u - NU_LAT, qb = v & 1, bh = v >> 1; b = bh / 6; h = bh - b * 6; qrow0 = NLAT + b * CTX + qb * 128; lat0 = 0; nlt = 0; ctx0 = NLAT + b * CTX; NT = CTX / 64; }
            const bf16_t* Qw = Qb + (size_t)(qrow0 + w4 * 32 + r32) * 768 + h * 128 + map * 64 + hi * 8;
            att::attn_unit<0, SHADOW_VAR>(Qw, Kb + h * 128, Vb + (size_t)h * 128 * NROW, nullptr, lat0, nlt, ctx0, NT, (bf16_t*)(big + B_XS) + 256 + h * 128, qrow0, lam, (const float*)kmax2 + (b * 6 + h) * 4, nullptr, (char*)lds, ldsl);
        }
#endif
    }
    SEAM(3);
    asm volatile("; ===PHASE 4");
    REP(4) if (IN(4)) { const int tid = opaque_tid(), lane = tid & 63; (void)tid; (void)lane; PHASE_PTRS
        pg8::Gemm g{(const bf16_t*)(big + B_MIX), Wb + W_OUT0 / 2, NROW, D, D, nullptr, 0}; pg8::StaticOrder S; S.init(NROW, D, G, bx);
        epi::EpiRes<false> E{INP(I_X), HS, INP(I_CTX), HC, modv + 2 * D};
        pg8::gemm_run<epi::EpiRes<false>, true, true>(ldsl, g, S, E);
#if TAIL_PROBE == 4
        for (int rp_ = 0; rp_ < 4; ++rp_) pg8::gemm_tail<epi::EpiRes<false>>(ldsl, g, S, E);
#endif
    }
    SEAM(4);
    asm volatile("; ===PHASE 5");
    REP(5) if (IN(5)) { const int tid = opaque_tid(), lane = tid & 63; (void)tid; (void)lane; PHASE_PTRS norm_phase<true>(HS, HC, INP(I_N2G), modv, 3, Abuf, NROW, gw, ngw, lane);
#if REPEAT_PHASE == 105
        norm_phase<true>(HS, HC, INP(I_N2G), modv, 3, Abuf, NROW, gw, ngw, lane);
#endif
    }
    SEAM(5);
    asm volatile("; ===PHASE 6");
    REP(6) if (IN(6)) { const int tid = opaque_tid(), lane = tid & 63; (void)tid; (void)lane; PHASE_PTRS
        pg8::Gemm g{Abuf, Wb + W_GU0 / 2, NROW, 2 * FF, D, nullptr, 0}; pg8::StaticOrder S; S.init(NROW, 2 * FF, G, bx);
        epi::EpiGU E{(bf16_t*)(big + B_HID)};
        pg8::gemm_run<epi::EpiGU, true, true>(ldsl, g, S, E);
#if TAIL_PROBE == 6
        for (int rp_ = 0; rp_ < 4; ++rp_) pg8::gemm_tail<epi::EpiGU>(ldsl, g, S, E);
#endif
    }
    SEAM(6);
    asm volatile("; ===PHASE 7");
    REP(7) if (IN(7)) { const int tid = opaque_tid(), lane = tid & 63; (void)tid; (void)lane; PHASE_PTRS
        pg8::Gemm g{(const bf16_t*)(big + B_HID), Wb + W_DN0 / 2, NROW, D, FF, nullptr, 0}; pg8::StaticOrder S; S.init(NROW, D, G, bx);
        epi::EpiRes<true> E{HS, HS, HC, HC, modv + 5 * D};
        pg8::gemm_run<epi::EpiRes<true>, true, true>(ldsl, g, S, E);
    }
    SEAM(7);
    asm volatile("; ===PHASE 8");
    REP(8) if (IN(8)) { const int tid = opaque_tid(), lane = tid & 63; (void)tid; (void)lane; PHASE_PTRS norm_phase<true>(HS, HC, INP(I_N1G) + D, modv + 3 * NMOD, 0, Abuf, NROW, gw, ngw, lane); }
    SEAM(8);
    asm volatile("; ===PHASE 9");
    REP(9) if (IN(9)) { const int tid = opaque_tid(), lane = tid & 63; (void)tid; (void)lane; PHASE_PTRS
        pg8::Gemm g{Abuf, Wb + W_IN1 / 2, NROW, D, D, nullptr, 0}; pg8::StaticOrder S; S.init(NROW, D, G, bx);
        epi::EpiIn1 E{(bf16_t*)(big + B_CQ), (bf16_t*)(big + B_CKV), (bf16_t*)(big + B_KR), ssq_q, ssq_kv, rope, krmax2};
        pg8::gemm_run<epi::EpiIn1, true, true>(ldsl, g, S, E);
    }
    SEAM(9);
    asm volatile("; ===PHASE 10");
    REP(10) if (IN(10)) { const int tid = opaque_tid(), lane = tid & 63; (void)tid; (void)lane; PHASE_PTRS
        { pg8::Gemm g{(const bf16_t*)(big + B_CQ), Wb + W_UQ / 2, NLAT, 1536, 512, nullptr, 0}; pg8::StaticOrder S; S.init(NLAT, 1536, G, bx);
          epi::EpiUQ E{(bf16_t*)(big + B_Q1), ssq_q, rope};
          pg8::gemm_run<epi::EpiUQ, true, true>(ldsl, g, S, E); }
        { pg8::Gemm g{(const bf16_t*)(big + B_CKV), Wb + W_UKV / 2, NROW, 2048, 256, nullptr, 0}; pg8::StaticOrder S; S.init(NROW, 2048, G, bx);
          epi::EpiUKV E{(bf16_t*)(big + B_KV1), ssq_kv, knmax2, (bf16_t*)(big + B_VT1), ldsl + 144 * 1024};
          pg8::gemm_run<epi::EpiUKV, true, true>(ldsl, g, S, E); }
    }
    SEAM(10);
    asm volatile("; ===PHASE 11");
    REP(11) if (IN(11)) { const int tid = opaque_tid(), lane = tid & 63; (void)tid; (void)lane; PHASE_PTRS
        const bf16_t* Q1 = (const bf16_t*)(big + B_Q1); const bf16_t* KV1 = (const bf16_t*)(big + B_KV1); const bf16_t* KR = (const bf16_t*)(big + B_KR);
        const int r32 = lane & 31, hi = lane >> 5;
        constexpr int NU = NB * 8 * (SEQ / 256);
        const int vbx11 = (G == 256) ? ((bx & 7) * 32 + (bx >> 3)) : bx;
        for (int u = vbx11; u < NU; u += G) {
            const int qb = u & 63, bh = u >> 6, b = bh >> 3, h = bh & 7, qrow0 = b * SEQ + qb * 256;
            const bf16_t* Qw = Q1 + (size_t)(qrow0 + wave * 32 + r32) * 1536 + h * 192 + hi * 8;
            att::attn_unit<1>(Qw, KV1 + h * 256, (const bf16_t*)(big + B_VT1) + (size_t)h * 128 * NROW, KR, b * SEQ, SEQ / 64, NLAT + b * CTX, SEQ / 64 + CTX / 64, Abuf + h * 128, qrow0, 0.f, (const float*)knmax2 + (b * 8 + h) * 4, (const float*)krmax2 + b * 2, (char*)lds, ldsl);
        }
    }
    SEAM(11);
#define MOE_WCONV() do { LAS float* scr = (LAS float*)(ldsl + wave * 16384); bf16_t* WM = (bf16_t*)(big + B_WM); \
        constexpr int N_G = 16 * 88, N_D = 44 * 32, PER_E = 2 * N_G + N_D; \
        for (int it = gw; it < NEXP * PER_E; it += ngw) { \
            const int e = it / PER_E; int r = it - e * PER_E; bf16_t* we = WM + (size_t)e * ESTRIDE; \
            if (r < N_G) { tr_item(INP(I_MG) + (size_t)e * D * FF, FF, r, nullptr, we, D, 1, scr, lane); continue; } r -= N_G; \
            if (r < N_G) { tr_item(INP(I_MU) + (size_t)e * D * FF, FF, r, nullptr, we, D, 2, scr, lane); continue; } r -= N_G; \
            tr_item(INP(I_MD) + (size_t)e * FF * D, D, r, nullptr, we + (size_t)2 * FF * D, FF, 0, scr, lane); } } while (0)
    asm volatile("; ===PHASE 12");
    REP(12) if (IN(12)) { const int tid = opaque_tid(), lane = tid & 63; (void)tid; (void)lane; PHASE_PTRS
        pg8::Gemm g{Abuf, Wb + W_OUT1 / 2, NLAT, D, D, nullptr, 0}; pg8::StaticOrder S; S.init(NLAT, D, G, bx);
        epi::EpiRes<true> E{HS, HS, HC, HC, modv + 3 * NMOD + 2 * D};
        const bool conv_first = ((bx >> 3) & 1) == 0;
        if (conv_first) { MOE_WCONV(); __syncthreads(); }
        pg8::gemm_run<epi::EpiRes<true>, true, true>(ldsl, g, S, E);
        if (!conv_first) { __syncthreads(); MOE_WCONV(); }
    }
    SEAM(12);
    asm volatile("; ===PHASE 13");
    if (IN(13)) { const int tid = opaque_tid(), lane = tid & 63; (void)tid; (void)lane; PHASE_PTRS
        volatile LAS int* re = (volatile LAS int*)(ldsl + MISC_OFF + 256);
        volatile LAS float* rw = (volatile LAS float*)(ldsl + MISC_OFF + 256 + 1024);
        {
            f32x4 rwr[4][4][2];
#pragma unroll
            for (int j = 0; j < 4; ++j)
#pragma unroll
                for (int c = 0; c < 4; ++c) { const float* p = INP(I_RTW) + (size_t)(4 * (64 * j + lane) + c) * 8; rwr[j][c][0] = *(const f32x4*)p; rwr[j][c][1] = *(const f32x4*)(p + 4); }
            const float* mv = modv + 3 * NMOD + ((bx * 128) >> 14) * NMOD; const float* ng2 = INP(I_N2G) + D;
            f32x4 gm[4], sv[4];
#pragma unroll
            for (int j = 0; j < 4; ++j) { gm[j] = ((const f32x4*)ng2)[64 * j + lane] * (((const f32x4*)(mv + 4 * D))[64 * j + lane] + 1.0f); sv[j] = ((const f32x4*)(mv + 3 * D))[64 * j + lane]; }
            for (int it = 0; it < 16; it += 2) {
                const int tl = wave * 16 + it, m = bx * 128 + tl;
                const u32x2* x0 = (const u32x2*)(HS + (size_t)m * D) + lane; const u32x2* x1 = x0 + D / 4;
                f32x4 a[2][4]; float ss[2] = {0.f, 0.f}; u32x2 ra[2][4];
#pragma unroll
                for (int j = 0; j < 4; ++j) { ra[0][j] = x0[64 * j]; ra[1][j] = x1[64 * j]; }
#pragma unroll
                for (int j = 0; j < 4; ++j) { a[0][j] = epi::bf4_f(ra[0][j].x, ra[0][j].y); a[1][j] = epi::bf4_f(ra[1][j].x, ra[1][j].y); }
#pragma unroll
                for (int q = 0; q < 2; ++q)
#pragma unroll
                    for (int j = 0; j < 4; ++j) ss[q] += (a[q][j][0] * a[q][j][0] + a[q][j][1] * a[q][j][1]) + (a[q][j][2] * a[q][j][2] + a[q][j][3] * a[q][j][3]);
#pragma unroll
                for (int o = 1; o < 64; o <<= 1) { ss[0] += __shfl_xor(ss[0], o); ss[1] += __shfl_xor(ss[1], o); }
                float k1[2];
#pragma unroll
                for (int q = 0; q < 2; ++q) { const float r = 1.0f / sqrtf(ss[q] * (1.0f / D) + EPS); u32x2* o8 = (u32x2*)(Abuf + (size_t)(m + q) * D) + lane;
                    f32x4 l0 = {0.f, 0.f, 0.f, 0.f}, l1 = {0.f, 0.f, 0.f, 0.f};
#pragma unroll
                    for (int j = 0; j < 4; ++j) { const f32x4 y = (a[q][j] * r) * gm[j] + sv[j]; u32x2 w; w.x = cvtpk(y[0], y[1]); w.y = cvtpk(y[2], y[3]); o8[64 * j] = w;
#pragma unroll
                        for (int c = 0; c < 4; ++c) { l0 += rwr[j][c][0] * y[c]; l1 += rwr[j][c][1] * y[c]; } }
                    const bool h5 = (lane & 32) != 0, h4 = (lane & 16) != 0, h3 = (lane & 8) != 0; float k4[4], k2[2];
#pragma unroll
                    for (int i = 0; i < 4; ++i) { const float mine = h5 ? l1[i] : l0[i], send = h5 ? l0[i] : l1[i]; k4[i] = mine + __shfl_xor(send, 32); }
#pragma unroll
                    for (int i = 0; i < 2; ++i) { const float mine = h4 ? k4[2 + i] : k4[i], send = h4 ? k4[i] : k4[2 + i]; k2[i] = mine + __shfl_xor(send, 16); }
                    { const float mine = h3 ? k2[1] : k2[0], send = h3 ? k2[0] : k2[1]; k1[q] = mine + __shfl_xor(send, 8); }
                    k1[q] += __shfl_xor(k1[q], 4); k1[q] += __shfl_xor(k1[q], 2); k1[q] += __shfl_xor(k1[q], 1); }
#pragma unroll
                for (int q = 0; q < 2; ++q) { float lg[8];
#pragma unroll
                    for (int e = 0; e < 8; ++e) lg[e] = __uint_as_float(__builtin_amdgcn_readlane(__float_as_uint(k1[q]), 32 * (e >> 2) + 16 * ((e >> 1) & 1) + 8 * (e & 1)));
                    int e1 = 0; float m1 = lg[0];
#pragma unroll
                    for (int e = 1; e < 8; ++e) if (lg[e] > m1) { m1 = lg[e]; e1 = e; }
                    int e2 = -1; float m2 = -3.0e38f;
#pragma unroll
                    for (int e = 0; e < 8; ++e) if (e != e1 && lg[e] > m2) { m2 = lg[e]; e2 = e; }
                    const float x2 = expf(m2 - m1), w1 = 1.0f / (1.0f + x2), w2 = x2 / (1.0f + x2);
                    if (lane == 0) { re[tl + q] = e1; re[128 + tl + q] = e2; rw[tl + q] = w1; rw[128 + tl + q] = w2; } }
            }
        }
        __syncthreads();
        if (wave < 2 && G == 256) {
            const int s = wave; const int ea = re[s * 128 + lane], eb = re[s * 128 + 64 + lane]; const float wa = rw[s * 128 + lane], wb = rw[s * 128 + 64 + lane];
            const unsigned long long ltm = (1ull << lane) - 1ull;
#pragma unroll
            for (int e = 0; e < 8; ++e) {
                const unsigned long long ma = __ballot(ea == e), mb = __ballot(eb == e);
                const int ca = __popcll(ma), cb = __popcll(mb);
                int base = 0; if (lane == 0 && ca + cb > 0) base = (int)atomicAdd(ctl + CW_CNT + 64 * (s * 8 + e), (unsigned)(ca + cb));
                base = __builtin_amdgcn_readfirstlane(base);
                if (ea == e) { const int pos = base + __popcll(ma & ltm); midx[(size_t)(s * 8 + e) * NLAT + pos] = bx * 128 + lane; mwgt[(size_t)(s * 8 + e) * NLAT + pos] = wa; }
                if (eb == e) { const int pos = base + ca + __popcll(mb & ltm); midx[(size_t)(s * 8 + e) * NLAT + pos] = bx * 128 + 64 + lane; mwgt[(size_t)(s * 8 + e) * NLAT + pos] = wb; }
            }
        }
    }
    SEAM(13);
#define MOE_PREFIX(s) do { __syncthreads(); if (tid < 8) MISC[32 + tid] = __hip_atomic_load(ctl + CW_CNT + 64 * ((s) * 8 + tid), __ATOMIC_RELAXED, __HIP_MEMORY_SCOPE_AGENT); __syncthreads(); \
        if (tid == 0) { int acc_ = 0; for (int e = 0; e < 8; ++e) { MISC[16 + e] = (unsigned)acc_; acc_ += ((int)MISC[32 + e] + 255) >> 8; } MISC[16 + 8] = (unsigned)acc_; } __syncthreads(); } while (0)
#define MOE_GATHER(s) do { const int np_ = (int)MISC[16 + 8]; bf16_t* XS = (bf16_t*)(big + B_XS); \
        for (int r0_ = gw * 4; r0_ < np_ * 256; r0_ += ngw * 4) { int tok_[4]; \
            _Pragma("unroll") for (int q_ = 0; q_ < 4; ++q_) { const int r_ = r0_ + q_; const int pm_ = r_ >> 8; int e_ = 0; for (int k = 1; k < 8; ++k) e_ += (pm_ >= (int)MISC[16 + k]) ? 1 : 0; \
                const int pos_ = r_ - ((int)MISC[16 + e_] << 8); tok_[q_] = pos_ < (int)MISC[32 + e_] ? midx[(size_t)((s) * 8 + e_) * NLAT + pos_] : 0; } \
            u32x4 d_[4][2]; \
            _Pragma("unroll") for (int q_ = 0; q_ < 4; ++q_) { const u32x4* src_ = (const u32x4*)(Abuf + (size_t)tok_[q_] * D); d_[q_][0] = src_[lane]; d_[q_][1] = src_[64 + lane]; } \
            _Pragma("unroll") for (int q_ = 0; q_ < 4; ++q_) { u32x4* dst_ = (u32x4*)(XS + (size_t)(r0_ + q_) * D); dst_[lane] = d_[q_][0]; dst_[64 + lane] = d_[q_][1]; } } } while (0)
#define MOE_GU(s) do { const int np_ = (int)MISC[16 + 8]; pg8::Gemm g{Abuf, (const bf16_t*)(big + B_WM), np_ * 256, 2 * FF, D, (const volatile LAS int*)(MISC + 16), ESTRIDE, midx + (size_t)(s) * 8 * NLAT, (const volatile LAS int*)(MISC + 32)}; \
        pg8::StaticOrder S; S.init(np_ * 256, 2 * FF, G, bx); epi::EpiGU E{(bf16_t*)(big + B_HIDM)}; pg8::gemm_run<epi::EpiGU, true, true, true>(ldsl, g, S, E); } while (0)
#define MOE_DOWN(s) do { const int np_ = (int)MISC[16 + 8]; pg8::Gemm g{(const bf16_t*)(big + B_HIDM), (const bf16_t*)(big + B_WM) + (size_t)2 * FF * D, np_ * 256, D, FF, (const volatile LAS int*)(MISC + 16), ESTRIDE}; \
        pg8::StaticOrder S; S.init(np_ * 256, D, G, bx); epi::EpiMoeDown E{HS, (s) == 1 ? Abuf : HS, modv + 3 * NMOD + 5 * D, midx + (size_t)(s) * 8 * NLAT, mwgt + (size_t)(s) * 8 * NLAT, (const volatile LAS int*)(MISC + 16), (const volatile LAS int*)(MISC + 32)}; \
        pg8::gemm_run<epi::EpiMoeDown, true, true>(ldsl, g, S, E); } while (0)
    asm volatile("; ===PHASE 15");
    REP(15) if (IN(15)) { const int tid = opaque_tid(), lane = tid & 63; (void)tid; (void)lane; PHASE_PTRS MOE_PREFIX(0); MOE_GU(0); }
    SEAM(15);
    asm volatile("; ===PHASE 16");
    REP(16) if (IN(16)) { const int tid = opaque_tid(), lane = tid & 63; (void)tid; (void)lane; PHASE_PTRS MOE_PREFIX(0); MOE_DOWN(0); }
    SEAM(16);
    asm volatile("; ===PHASE 17");
    REP(17) if (IN(17)) { const int tid = opaque_tid(), lane = tid & 63; (void)tid; (void)lane; PHASE_PTRS MOE_PREFIX(1); MOE_GU(1); }
    SEAM(17);
    asm volatile("; ===PHASE 18");
    REP(18) if (IN(18)) { const int tid = opaque_tid(), lane = tid & 63; (void)tid; (void)lane; PHASE_PTRS MOE_PREFIX(1); MOE_DOWN(1); }
    SEAM(18);
    asm volatile("; ===PHASE 19");
    REP(19) if (IN(19)) { const int tid = opaque_tid(), lane = tid & 63; (void)tid; (void)lane; PHASE_PTRS
        const float* fg = INP(I_FNG); float* out19 = OUT;
        f32x4 fgv[4];
#pragma unroll
        for (int j = 0; j < 4; ++j) fgv[j] = ((const f32x4*)fg)[64 * j + lane];
        for (int m = gw * 2; m < NLAT; m += ngw * 2) {
            f32x4* x0 = (f32x4*)(out19 + (size_t)m * D) + lane; f32x4* x1 = x0 + D / 4; f32x4 a[4], b[4]; float s0 = 0.f, s1 = 0.f;
            const u32x2* y0 = (const u32x2*)(Abuf + (size_t)m * D) + lane; const u32x2* y1 = y0 + D / 4; u32x2 ra[4], rb[4];
#pragma unroll
            for (int j = 0; j < 4; ++j) { ra[j] = y0[64 * j]; rb[j] = y1[64 * j]; }
#pragma unroll
            for (int j = 0; j < 4; ++j) { a[j] = epi::bf4_f(ra[j].x, ra[j].y); b[j] = epi::bf4_f(rb[j].x, rb[j].y); }
#pragma unroll
            for (int j = 0; j < 4; ++j) { s0 += (a[j][0] * a[j][0] + a[j][1] * a[j][1]) + (a[j][2] * a[j][2] + a[j][3] * a[j][3]); s1 += (b[j][0] * b[j][0] + b[j][1] * b[j][1]) + (b[j][2] * b[j][2] + b[j][3] * b[j][3]); }
#pragma unroll
            for (int o = 1; o < 64; o <<= 1) { s0 += __shfl_xor(s0, o); s1 += __shfl_xor(s1, o); }
            const float r0 = 1.0f / sqrtf(s0 * (1.0f / D) + EPS), r1 = 1.0f / sqrtf(s1 * (1.0f / D) + EPS);
#pragma unroll
            for (int j = 0; j < 4; ++j) { x0[64 * j] = a[j] * r0 * fgv[j]; x1[64 * j] = b[j] * r1 * fgv[j]; }
        }
    }
#undef IN
#undef SEAM
}

#ifndef N_LAUNCH_MODE
#define N_LAUNCH_MODE 1
#endif
extern "C" void kernel_launch(void* const* d_in, const int* in_sizes, int n_in, void* d_out, int out_size, void* d_ws, size_t ws_size, hipStream_t stream) {
    static int grid = 0;
    if (grid == 0) {
        if (n_in != 30 || out_size != NLAT * D || ws_size < WS_END) { fprintf(stderr, "kernel_launch: unexpected shapes: n_in %d out %d ws %zu (need %zu)\n", n_in, out_size, ws_size, (size_t)WS_END); grid = -1; return; }
        int dev = 0, cus = 0, per_cu = 0;
        if (hipGetDevice(&dev) != hipSuccess || hipDeviceGetAttribute(&cus, hipDeviceAttributeMultiprocessorCount, dev) != hipSuccess) { grid = -1; return; }
        if (hipFuncSetAttribute((const void*)fwd_kernel, hipFuncAttributeMaxDynamicSharedMemorySize, LDS_BYTES) != hipSuccess) { fprintf(stderr, "kernel_launch: hipFuncSetAttribute failed\n"); grid = -1; return; }
        if (hipOccupancyMaxActiveBlocksPerMultiprocessor(&per_cu, (const void*)fwd_kernel, NTHR, LDS_BYTES) != hipSuccess || per_cu < 1) fprintf(stderr, "kernel_launch: occupancy query reports %d\n", per_cu);
        (void)hipGetLastError();
        grid = cus;
        if (grid != 256) { fprintf(stderr, "kernel_launch: built for 256 CUs, found %d\n", grid); grid = -1; return; }
    }
    if (grid < 0) return;
    if (hipMemsetAsync((char*)d_ws + WS_CTL, 0, CTL_ZERO_BYTES, stream) != hipSuccess) return;
    Args a{};
    for (int i = 0; i < 30; ++i) a.in[i] = (const float*)d_in[i];
    a.out = (float*)d_out; a.ws = (unsigned char*)d_ws;
    constexpr int NPH = 20;
    if (N_LAUNCH_MODE == 1) { a.ph_lo = 0; a.ph_hi = NPH; hipLaunchKernelGGL(fwd_kernel, dim3(grid), dim3(NTHR), LDS_BYTES, stream, a); }
    else { for (int p = 0; p < NPH; ++p) { a.ph_lo = p; a.ph_hi = p + 1; hipLaunchKernelGGL(fwd_kernel, dim3(grid), dim3(NTHR), LDS_BYTES, stream, a); } }
    const hipError_t le = hipPeekAtLastError();
    if (le != hipSuccess) fprintf(stderr, "kernel_launch: launch failed: %s\n", hipGetErrorName(le));
}
```

```cpp
#include <hip/hip_runtime.h>
#include <cstdio>
#include <cstdint>

#define GAS __attribute__((address_space(1)))
#define LAS __attribute__((address_space(3)))
typedef unsigned short bf16_t;
typedef short bf16x8 __attribute__((ext_vector_type(8)));
typedef short s16x4 __attribute__((ext_vector_type(4)));
typedef float f32x4 __attribute__((ext_vector_type(4)));
typedef float f32x2 __attribute__((ext_vector_type(2)));
typedef float f32x16 __attribute__((ext_vector_type(16)));
typedef unsigned u32x4 __attribute__((ext_vector_type(4)));
typedef unsigned u32x2 __attribute__((ext_vector_type(2)));

constexpr int D = 1024, NB = 2, SEQ = 16384, CTX = 256, NLAT = NB * SEQ, NCTX = NB * CTX, NROW = NLAT + NCTX;
constexpr int FF = 2816, NEXP = 8, NMOD = 6 * D;
constexpr int NW = 8, NTHR = 512;
constexpr float EPS = 1e-6f;
constexpr float LOG2E = 1.4426950408889634f;
constexpr float QSC0 = 0.125f * LOG2E;
constexpr float QSC1 = 0.07216878364870322f * LOG2E;
constexpr float LAM_INIT0 = 0.2f;

constexpr size_t MiB = 1u << 20;
constexpr size_t WS_CTL = 0, CTL_ZERO_BYTES = 2 * MiB;
constexpr int CW_BAR = 4096;
constexpr int CW_CNT = 8192;
constexpr size_t CTL_SSQQ = 256 * 1024, CTL_SSQKV = 512 * 1024;
constexpr size_t WS_TAB = 2 * MiB;
constexpr size_t TAB_ROPE = 256 * 1024, TAB_IDX = 1 * MiB, TAB_WGT = 3 * MiB;
constexpr size_t WS_HC = 10 * MiB;
constexpr size_t WS_W = 12 * MiB;
constexpr size_t W_IN0 = 0, W_OUT0 = 5 * MiB, W_GU0 = 7 * MiB, W_DN0 = 18 * MiB, W_IN1 = 24 * MiB, W_UQ = 26 * MiB, W_UKV = 28 * MiB, W_OUT1 = 29 * MiB;
constexpr size_t WS_A = 44 * MiB;
constexpr size_t WS_BIG = 109 * MiB;
constexpr size_t B_P = 0, B_Q = (size_t)NROW * 256 * 4, B_K = B_Q + (size_t)NROW * 768 * 2, B_V = B_K + (size_t)NROW * 768 * 2, B_MIX = B_V + (size_t)NROW * 768 * 2;
constexpr size_t B_HID = 0;
constexpr size_t B_CQ = 0, B_CKV = B_CQ + (size_t)NROW * 512 * 2, B_KR = B_CKV + (size_t)NROW * 256 * 2, B_Q1 = 53 * MiB, B_KV1 = 149 * MiB;
constexpr size_t B_VT1 = 279 * MiB;
static_assert(B_KR + (size_t)NROW * 64 * 2 <= B_Q1 && B_VT1 + (size_t)1024 * NROW * 2 <= 387 * MiB, "L1 map");
constexpr size_t ESTRIDE = (size_t)2 * FF * D + (size_t)D * FF;
constexpr size_t B_WM = 0, B_HIDM = 132 * MiB, B_XS = 319 * MiB, BIG_END = 387 * MiB;
constexpr int MAXPAN = 136;
static_assert(NEXP * ESTRIDE * 2 <= B_HIDM && B_HIDM + (size_t)MAXPAN * 256 * FF * 2 <= B_XS && B_XS + (size_t)MAXPAN * 256 * D * 2 <= BIG_END, "MoE map");
constexpr size_t WS_END = WS_BIG + BIG_END;

constexpr int RING_BYTES = 131072, MISC_OFF = 156 * 1024, LDS_BYTES = MISC_OFF + 4096;

#define LDS_WAIT() asm volatile("s_waitcnt lgkmcnt(0)" ::: "memory")
#define VM_WAIT() asm volatile("s_waitcnt vmcnt(0)" ::: "memory")
__device__ __forceinline__ unsigned f2bf(float f) { unsigned u = __builtin_bit_cast(unsigned, f); return (u + 0x7fffu + ((u >> 16) & 1u)) >> 16; }
__device__ __forceinline__ unsigned pk2(float lo, float hi) { return f2bf(lo) | (f2bf(hi) << 16); }
__device__ __forceinline__ unsigned cvtpk(float lo, float hi) { unsigned r; asm volatile("v_cvt_pk_bf16_f32 %0, %1, %2" : "=v"(r) : "v"(lo), "v"(hi)); return r; }
__device__ __forceinline__ int opaque_tid() { int t = threadIdx.x; asm volatile("" : "+v"(t)); return t; }
__device__ __forceinline__ float wave_sum(float v) {
#pragma unroll
    for (int o = 1; o < 64; o <<= 1) v += __shfl_xor(v, o);
    return v;
}

#define XB_TMO      128
#define XB_XCNT(j)  (256  + 64 * (j))
#define XB_XSUB(j)  (1280 + 64 * (j))
#define XB_XGEN(j)  (2304 + 64 * (j))
#define XB_TOP      3328
#define XB_TOPGEN   3392
#define XCD_BAR_WORDS 3456
#define XB_SPIN_CAP (1u << 18)
__device__ __forceinline__ unsigned xb_ld(unsigned* p)              { return __hip_atomic_load(p, __ATOMIC_RELAXED, __HIP_MEMORY_SCOPE_AGENT); }
__device__ __forceinline__ unsigned xb_add(unsigned* p, unsigned v) { return __hip_atomic_fetch_add(p, v, __ATOMIC_RELAXED, __HIP_MEMORY_SCOPE_AGENT); }
__device__ __forceinline__ unsigned xb_xcc_id() { return (unsigned)__builtin_amdgcn_s_getreg((3 << 11) | 20) & 0xFu; }
#define XB_SPIN(cond, bar) do { unsigned _sp = 0; while (cond) { __builtin_amdgcn_s_sleep(1); \
    if ((++_sp & 255u) == 0u) { if (xb_ld(&(bar)[XB_TMO])) break; if (_sp > XB_SPIN_CAP) { atomicAdd(&(bar)[XB_TMO], 1u); break; } } } } while (0)
struct XcdBarrier { unsigned* bar; unsigned x; volatile LAS unsigned* st; };
__device__ __forceinline__ XcdBarrier xcd_barrier_post(unsigned* bar, volatile LAS unsigned* st) {
    XcdBarrier b; b.bar = bar; b.x = xb_xcc_id(); b.st = st;
    if (threadIdx.x == 0) (void)xb_add(&bar[XB_XCNT(b.x)], 1u);
    return b;
}
__device__ __forceinline__ void xcd_barrier_complete(unsigned* bar, unsigned x, unsigned& nloc, unsigned& nx) {
    const unsigned G = gridDim.x * gridDim.y * gridDim.z;
    unsigned sum, cnt, mine, sp = 0u;
    for (;;) {
        sum = 0u; cnt = 0u; mine = 0u;
#pragma unroll
        for (unsigned j = 0; j < 16; ++j) { const unsigned c = xb_ld(&bar[XB_XCNT(j)]); sum += c; cnt += (c > 0u) ? 1u : 0u; mine = (j == x) ? c : mine; }
        if (sum == G) break;
        __builtin_amdgcn_s_sleep(1);
        if ((++sp & 255u) == 0u) { if (xb_ld(&bar[XB_TMO])) break; if (sp > XB_SPIN_CAP) { atomicAdd(&bar[XB_TMO], 1u); break; } }
    }
    nloc = mine > 0u ? mine : 1u; nx = cnt > 0u ? cnt : 1u;
}
__device__ __forceinline__ void xcd_barrier(const XcdBarrier& b) {
    asm volatile("s_waitcnt vmcnt(0)" ::: "memory");
    __syncthreads();
    if (threadIdx.x == 0) {
        unsigned* bar = b.bar;
        __builtin_amdgcn_s_waitcnt(0);
        unsigned nloc = b.st[0], nx = b.st[1];
        if (nloc == 0u) { xcd_barrier_complete(bar, b.x, nloc, nx); b.st[0] = nloc; b.st[1] = nx; }
        const unsigned old = xb_add(&bar[XB_XSUB(b.x)], 1u);
        const unsigned gen = old / nloc;
        if (old + 1u == (gen + 1u) * nloc) {
            __builtin_amdgcn_fence(__ATOMIC_RELEASE, "agent");
            asm volatile("s_waitcnt vmcnt(0)" ::: "memory");
            const unsigned og = xb_add(&bar[XB_TOP], 1u);
            const unsigned tg = og / nx;
            if (og + 1u == (tg + 1u) * nx) xb_add(&bar[XB_TOPGEN], 1u);
            else XB_SPIN(xb_ld(&bar[XB_TOPGEN]) == tg, bar);
            __builtin_amdgcn_fence(__ATOMIC_ACQUIRE, "agent");
            xb_add(&bar[XB_XGEN(b.x)], 1u);
            asm volatile("s_waitcnt vmcnt(0)" ::: "memory");
        } else {
            XB_SPIN(xb_ld(&bar[XB_XGEN(b.x)]) == gen, bar);
            __builtin_amdgcn_fence(__ATOMIC_ACQUIRE, "agent");
            asm volatile("s_waitcnt vmcnt(0)" ::: "memory");
        }
    }
    __syncthreads();
}

namespace pg8 {
constexpr int BM = 256, BK = 64, HALF = 128, HTB = HALF * BK * 2, STAGE_BYTES = 8 * HTB, NXCD = 8, WGM = 4;
__host__ __device__ __forceinline__ int lds_byte(int r, int c) { const int st = (r >> 4) * 2 + (c >> 5), rr = r & 15, cc = c & 31, ob = rr * 64 + cc * 2; return st * 1024 + (ob ^ (((ob >> 9) & 1) << 5)); }
__host__ __device__ __forceinline__ void stage_rc(int b, int& R, int& C) { const int st = b / 1024, sb = b % 1024, swz = sb ^ (((sb >> 9) & 1) << 5); R = (st >> 1) * 16 + swz / 64; C = (st & 1) * 32 + (swz % 64) / 2; }
__host__ __device__ __forceinline__ int perm32(int rho) { const int n = rho >> 4, i = rho & 15; return 8 * (i >> 2) + 4 * n + (i & 3); }
struct Unit { int pm, pn; };
struct Gemm { const bf16_t* A; const bf16_t* Bt; int M, N, K; const volatile LAS int* pb; size_t estride; const int* gidx; const volatile LAS int* gcnt; };
constexpr int TOKBUF = 152 * 1024;
#ifndef TAIL_MAX
#define TAIL_MAX 64
#endif
struct StaticOrder {
    int nM, nN, nwg, G, c, nmain;
    __host__ __device__ void init(int M, int N, int G_, int c_) { nM = M / BM; nN = N / BM; nwg = nM * nN; G = G_; c = c_; const int rem = nwg % G; nmain = (rem > 0 && rem <= TAIL_MAX) ? nwg - rem : nwg; }
    __host__ __device__ bool next(int i, Unit& u) const {
        const long L = (long)i * G + c; if (L >= nmain) return false;
        map((int)L, u); return true;
    }
    __host__ __device__ void map(int L, Unit& u) const {
        int wgid = L; { const int q = nwg / NXCD, r = nwg % NXCD, xcd = wgid % NXCD, off = wgid / NXCD; wgid = (xcd < r ? xcd * (q + 1) : r * (q + 1) + (xcd - r) * q) + off; }
        const int nig = WGM * nN, gid = wgid / nig, fm = gid * WGM, gsz = (nM - fm) < WGM ? (nM - fm) : WGM;
        u.pm = fm + ((wgid % nig) % gsz); u.pn = (wgid % nig) / gsz;
    }
};
__device__ __forceinline__ const char* b_tile(const Gemm& g, const Unit& u, size_t tstep) {
    const char* p = (const char*)g.Bt + (size_t)u.pn * tstep;
    if (g.pb) { int e = 0;
#pragma unroll
        for (int k = 1; k < 8; ++k) e += (u.pm >= g.pb[k]) ? 1 : 0;
        p += (size_t)e * g.estride * 2; }
    return p;
}

template <class Epi, bool ALIGN_EPI = false, bool SP2 = false, bool GATH = false>
__device__ __forceinline__ void gemm_phase(LAS unsigned char* lds, const Gemm g, const StaticOrder& S, const Epi& E) {
    static_assert(!GATH || SP2, "gathered A rows: SP2 loop only");
    const int tid = opaque_tid(), wid = __builtin_amdgcn_readfirstlane(tid >> 6), lane = tid & 63, wr = wid >> 2, wc = wid & 3, fr = lane & 15, fq = lane >> 4;
    const int K = g.K, nt = K / BK;
    unsigned voffA[2], voffB[2];
#pragma unroll
    for (int i = 0; i < 2; ++i) { int R, C; stage_rc(tid * 16 + i * 8192, R, C); const int Rb = Epi::PERM ? ((R & ~31) + perm32(R & 31)) : R;
        voffA[i] = (unsigned)(R * K + C) * 2u; voffB[i] = (unsigned)(Rb * K + C) * 2u; }
    const size_t kstep = (size_t)(BK * 2);
    const size_t hstep = (size_t)HALF * K * 2;
    const size_t tstep = 2 * hstep;
    const unsigned ldsw = (unsigned)wid * 1024u;
    const int aoff = lds_byte(wr * 64 + fr, fq * 8), boff = lds_byte(wc * 32 + fr, fq * 8);
#define PG8_SA(b, h) (((b) * 2 + (h)) * HTB)
#define PG8_SB(b, h) ((4 + (b) * 2 + (h)) * HTB)
#define PG8_STAGE(bufoff, gbase, voff) do { _Pragma("unroll") for (int _i = 0; _i < 2; ++_i) \
        __builtin_amdgcn_global_load_lds((const unsigned*)((const char*)(gbase) + (voff)[_i]), (LAS unsigned*)(lds + (bufoff) + ldsw + _i * 8192), 16, 0, 0); } while (0)
#define PG8_STAGE_A(bufoff, base, h, vv) do { if constexpr (GATH) PG8_STAGE(bufoff, base, (vv)[h]); else PG8_STAGE(bufoff, (base) + (h) * hstep, voffA); } while (0)
#define PG8_LDA(dst, b, h) do { _Pragma("unroll") for (int m = 0; m < 4; ++m) _Pragma("unroll") for (int k = 0; k < 2; ++k) dst[m][k] = *(const LAS bf16x8*)(lds + PG8_SA(b, h) + aoff + m * 2048 + k * 1024); } while (0)
#define PG8_LDB(dst, b, h) do { _Pragma("unroll") for (int n = 0; n < 2; ++n) _Pragma("unroll") for (int k = 0; k < 2; ++k) dst[n][k] = *(const LAS bf16x8*)(lds + PG8_SB(b, h) + boff + n * 2048 + k * 1024); } while (0)
#define PG8_MMA(ai, bj, At, Bt) do { __builtin_amdgcn_s_setprio(1); _Pragma("unroll") for (int m = 0; m < 4; ++m) _Pragma("unroll") for (int n = 0; n < 2; ++n) _Pragma("unroll") for (int k = 0; k < 2; ++k) \
        acc[ai][bj][m][n] = __builtin_amdgcn_mfma_f32_16x16x32_bf16(Bt[n][k], At[m][k], acc[ai][bj][m][n], 0, 0, 0); __builtin_amdgcn_s_setprio(0); } while (0)
#define PG8_WAIT_V(n) asm volatile("s_waitcnt vmcnt(" #n ")" ::: "memory")
#define PG8_WAIT_L(n) asm volatile("s_waitcnt lgkmcnt(" #n ")" ::: "memory")
#define PG8_BAR __builtin_amdgcn_s_barrier()
#define PG8_SCHED __builtin_amdgcn_sched_barrier(0)
    Unit cur, nxt; int ui = 0;
    if (!S.next(0, cur)) return;
    f32x4 acc[2][2][4][2];
#pragma unroll
    for (int a = 0; a < 2; ++a)
#pragma unroll
        for (int b = 0; b < 2; ++b)
#pragma unroll
            for (int m = 0; m < 4; ++m)
#pragma unroll
                for (int n = 0; n < 2; ++n) acc[a][b][m][n] = (f32x4){0.f, 0.f, 0.f, 0.f};
    bf16x8 At[4][2], B0[2][2], B1[2][2];
    unsigned cvA[2][2] = {{0u, 0u}, {0u, 0u}}, xvA[2][2] = {{0u, 0u}, {0u, 0u}};
    if constexpr (GATH) {
        int e = 0;
#pragma unroll
        for (int k = 1; k < 8; ++k) e += (cur.pm >= g.pb[k]) ? 1 : 0;
        const int lp = cur.pm - g.pb[e], n_e = g.gcnt[e];
#pragma unroll
        for (int i = 0; i < 2; ++i) { int R, C; stage_rc(tid * 16 + i * 8192, R, C);
#pragma unroll
            for (int h = 0; h < 2; ++h) { const int pos = lp * 256 + h * 128 + R; const int tok = pos < n_e ? g.gidx[(size_t)e * NLAT + pos] : 0; cvA[h][i] = (unsigned)(tok * K + C) * 2u; } }
    }
    const char* cA = GATH ? (const char*)g.A : (const char*)g.A + (size_t)cur.pm * tstep; const char* cB = b_tile(g, cur, tstep);
    if constexpr (SP2) {
        PG8_STAGE(PG8_SB(0, 0), cB, voffB); PG8_STAGE(PG8_SB(0, 1), cB + hstep, voffB); PG8_STAGE_A(PG8_SA(0, 0), cA, 0, cvA); PG8_STAGE_A(PG8_SA(0, 1), cA, 1, cvA);
        if (wr == 1) PG8_BAR;
        PG8_WAIT_V(2); PG8_BAR;
        PG8_STAGE(PG8_SB(1, 0), cB + kstep, voffB); PG8_STAGE_A(PG8_SA(1, 0), cA + kstep, 0, cvA); PG8_STAGE(PG8_SB(1, 1), cB + hstep + kstep, voffB);
        PG8_WAIT_V(6); PG8_BAR;
    } else {
        PG8_STAGE(PG8_SB(0, 0), cB, voffB); PG8_STAGE(PG8_SA(0, 0), cA, voffA); PG8_STAGE(PG8_SB(0, 1), cB + hstep, voffB); PG8_STAGE(PG8_SA(0, 1), cA + hstep, voffA);
        if (wr == 1) PG8_BAR;
        PG8_WAIT_V(4); PG8_BAR;
        PG8_STAGE(PG8_SB(1, 0), cB + kstep, voffB); PG8_STAGE(PG8_SA(1, 0), cA + kstep, voffA); PG8_STAGE(PG8_SB(1, 1), cB + hstep + kstep, voffB);
        PG8_WAIT_V(6); PG8_BAR;
    }
    for (;;) {
        const bool has_next = S.next(ui + 1, nxt);
        const char* nA = (has_next && !GATH) ? (const char*)g.A + (size_t)nxt.pm * tstep : cA; const char* nB = has_next ? b_tile(g, nxt, tstep) : cB;
        int ne = 0, nlp = 0, nn = 0;
        if constexpr (GATH) { if (has_next) {
#pragma unroll
            for (int k = 1; k < 8; ++k) ne += (nxt.pm >= g.pb[k]) ? 1 : 0;
            nlp = nxt.pm - g.pb[ne]; nn = g.gcnt[ne];
            if (wid == 0) __builtin_amdgcn_global_load_lds((const unsigned*)(g.gidx + (size_t)ne * NLAT + nlp * 256 + lane * 4), (LAS unsigned*)(lds + TOKBUF + ((ui + 1) & 1) * 1024), 16, 0, 0); } }
        for (int t = 0; t < nt; t += 2) {
            const bool last = (t == nt - 2);
            const char* a1 = cA + (size_t)(t + 1) * kstep;
            const char* a2 = last ? nA : cA + (size_t)(t + 2) * kstep; const char* b2 = last ? nB : cB + (size_t)(t + 2) * kstep;
            const char* a3 = a2 + kstep; const char* b3 = b2 + kstep;
            if constexpr (GATH) {
                if (last && has_next) {
                    int t2 = tid; asm volatile("" : "+v"(t2));
#pragma unroll
                    for (int i = 0; i < 2; ++i) { int R, C; stage_rc(t2 * 16 + i * 8192, R, C);
#pragma unroll
                        for (int h = 0; h < 2; ++h) { const int r = h * 128 + R; const int tok = (nlp * 256 + r < nn) ? *(const LAS int*)(lds + TOKBUF + ((ui + 1) & 1) * 1024 + r * 4) : 0; xvA[h][i] = (unsigned)(tok * K + C) * 2u; } }
                } else {
#pragma unroll
                    for (int i = 0; i < 2; ++i) { xvA[0][i] = cvA[0][i]; xvA[1][i] = cvA[1][i]; } }
            }
            if constexpr (SP2) {
            PG8_LDB(B0, 0, 0); PG8_LDB(B1, 0, 1); PG8_SCHED; PG8_LDA(At, 0, 0); PG8_STAGE_A(PG8_SA(1, 1), a1, 1, cvA);
            PG8_WAIT_V(8); PG8_WAIT_L(0); PG8_BAR; PG8_MMA(0, 0, At, B0); PG8_MMA(0, 1, At, B1); PG8_BAR; PG8_SCHED;
            PG8_LDA(At, 0, 1); PG8_STAGE(PG8_SB(0, 0), b2, voffB); PG8_STAGE(PG8_SB(0, 1), b2 + hstep, voffB); PG8_STAGE_A(PG8_SA(0, 0), a2, 0, xvA);
            PG8_WAIT_V(8); PG8_WAIT_L(0); PG8_BAR; PG8_MMA(1, 0, At, B0); PG8_MMA(1, 1, At, B1); PG8_BAR; PG8_SCHED;
            PG8_LDB(B0, 1, 0); PG8_LDB(B1, 1, 1); PG8_SCHED; PG8_LDA(At, 1, 0); PG8_STAGE_A(PG8_SA(0, 1), a2, 1, xvA);
            PG8_WAIT_V(8); PG8_WAIT_L(0); PG8_BAR; PG8_MMA(0, 0, At, B0); PG8_MMA(0, 1, At, B1); PG8_BAR; PG8_SCHED;
            PG8_LDA(At, 1, 1); PG8_STAGE(PG8_SB(1, 0), b3, voffB); PG8_STAGE(PG8_SB(1, 1), b3 + hstep, voffB); PG8_STAGE_A(PG8_SA(1, 0), a3, 0, xvA);
            PG8_WAIT_V(8); PG8_WAIT_L(0); PG8_BAR; PG8_MMA(1, 0, At, B0); PG8_MMA(1, 1, At, B1); PG8_BAR; PG8_SCHED;
            } else {
            PG8_LDB(B0, 0, 0); PG8_SCHED; PG8_LDA(At, 0, 0); PG8_STAGE(PG8_SA(1, 1), a1 + hstep, voffA);
            PG8_WAIT_L(8); PG8_BAR; PG8_WAIT_L(0); PG8_MMA(0, 0, At, B0); PG8_BAR; PG8_SCHED;
            PG8_LDB(B1, 0, 1); PG8_STAGE(PG8_SB(0, 0), b2, voffB);
            PG8_BAR; PG8_WAIT_L(0); PG8_MMA(0, 1, At, B1); PG8_BAR;
            PG8_LDA(At, 0, 1); PG8_STAGE(PG8_SA(0, 0), a2, voffA);
            PG8_BAR; PG8_WAIT_L(0); PG8_MMA(1, 0, At, B0); PG8_BAR; PG8_SCHED;
            PG8_STAGE(PG8_SB(0, 1), b2 + hstep, voffB);
            PG8_WAIT_V(6); PG8_BAR; PG8_MMA(1, 1, At, B1); PG8_BAR;
            PG8_LDB(B0, 1, 0); PG8_SCHED; PG8_LDA(At, 1, 0); PG8_STAGE(PG8_SA(0, 1), a2 + hstep, voffA);
            PG8_WAIT_L(8); PG8_BAR; PG8_WAIT_L(0); PG8_MMA(0, 0, At, B0); PG8_BAR; PG8_SCHED;
            PG8_LDB(B1, 1, 1); PG8_STAGE(PG8_SB(1, 0), b3, voffB);
            PG8_BAR; PG8_WAIT_L(0); PG8_MMA(0, 1, At, B1); PG8_BAR;
            PG8_LDA(At, 1, 1); PG8_STAGE(PG8_SA(1, 0), a3, voffA);
            PG8_BAR; PG8_WAIT_L(0); PG8_MMA(1, 0, At, B0); PG8_BAR; PG8_SCHED;
            PG8_STAGE(PG8_SB(1, 1), b3 + hstep, voffB);
            PG8_WAIT_V(6); PG8_BAR; PG8_MMA(1, 1, At, B1); PG8_BAR;
            }
        }
        if constexpr (ALIGN_EPI) { if (wr == 0) PG8_BAR; }
        E(acc, cur, wr, wc, fr, fq);
        if (!has_next) break;
#pragma unroll
        for (int a = 0; a < 2; ++a)
#pragma unroll
            for (int b = 0; b < 2; ++b)
#pragma unroll
                for (int m = 0; m < 4; ++m)
#pragma unroll
                    for (int n = 0; n < 2; ++n) acc[a][b][m][n] = (f32x4){0.f, 0.f, 0.f, 0.f};
        cur = nxt; cA = nA; cB = nB; ++ui;
        if constexpr (GATH) {
#pragma unroll
            for (int i = 0; i < 2; ++i) { cvA[0][i] = xvA[0][i]; cvA[1][i] = xvA[1][i]; } }
        if constexpr (ALIGN_EPI) { if (wr == 1) PG8_BAR; }
    }
    PG8_WAIT_V(0);
    if constexpr (!ALIGN_EPI) { if (wr == 0) PG8_BAR; }
    PG8_BAR;
#undef PG8_SA
#undef PG8_SB
#undef PG8_STAGE
#undef PG8_STAGE_A
#undef PG8_LDA
#undef PG8_LDB
#undef PG8_MMA
#undef PG8_WAIT_V
#undef PG8_WAIT_L
#undef PG8_BAR
#undef PG8_SCHED
}
template <class Epi, bool GATH = false>
__device__ __forceinline__ void gemm_tail(LAS unsigned char* lds, const Gemm g, const StaticOrder& S, const Epi& E) {
    const int ntail = S.nwg - S.nmain; if (ntail <= 0) return;
    const int tid = opaque_tid(), wid = __builtin_amdgcn_readfirstlane(tid >> 6), lane = tid & 63, wr = wid >> 2, wm = wid & 3, fr = lane & 15, fq = lane >> 4;
    const int K = g.K, nt = K / BK;
    unsigned voffA[2];
#pragma unroll
    for (int i = 0; i < 2; ++i) { int R, C; stage_rc(tid * 16 + i * 8192, R, C); voffA[i] = (unsigned)(R * K + C) * 2u; }
    const size_t kstep = (size_t)(BK * 2), hstep = (size_t)HALF * K * 2, tstep = 2 * hstep;
    const unsigned ldsw = (unsigned)wid * 1024u;
    const int aoff = lds_byte(wr * 64 + wm * 16 + fr, fq * 8), binner = lds_byte(fr, fq * 8);
    constexpr int SLOT = HTB + 8192, NS = 6, PF = NS - 1;
#define PT_DMA(src, dst) __builtin_amdgcn_global_load_lds((const unsigned*)(src), (LAS unsigned*)(dst), 16, 0, 0)
#define PT_STAGE(so, kt) do { LAS unsigned char* _l = lds + (so); const char* _a = cA + (size_t)(kt) * kstep; \
        PT_DMA(_a + voffA[0], _l + ldsw); PT_DMA(_a + voffA[1], _l + ldsw + 8192); PT_DMA(cBw + (size_t)(kt) * kstep, _l + HTB + ldsw); } while (0)
    const int nq = (ntail + 7) >> 3;
    for (int t = S.c; t < nq * 64; t += S.G) {
        const int q = (t & 7) + 8 * (t >> 6), sl = (t >> 3) & 7; if (q >= ntail) continue;
        Unit u; S.map(S.nmain + q, u); const int sai = sl >> 2, wcq = sl & 3;
        const char* cA = GATH ? (const char*)g.A : (const char*)g.A + (size_t)u.pm * tstep + (size_t)sai * hstep;
        if constexpr (GATH) {
            int e = 0;
#pragma unroll
            for (int k = 1; k < 8; ++k) e += (u.pm >= g.pb[k]) ? 1 : 0;
            const int lp = u.pm - g.pb[e], n_e = g.gcnt[e];
#pragma unroll
            for (int i = 0; i < 2; ++i) { int R, C; stage_rc(tid * 16 + i * 8192, R, C); const int pos = lp * 256 + sai * 128 + R; const int tok = pos < n_e ? g.gidx[(size_t)e * NLAT + pos] : 0; voffA[i] = (unsigned)(tok * K + C) * 2u; }
        }
        const char* cBw;
        { int R, C; stage_rc((4 * wcq + (wid & 3)) * 1024 + lane * 16, R, C); const int Rb = Epi::PERM ? ((R & ~31) + perm32(R & 31)) : R;
          cBw = b_tile(g, u, tstep) + (size_t)(wid >> 2) * hstep + (size_t)(Rb * K + C) * 2; }
        f32x4 acc[2][2][4][2];
        acc[0][0][0][0] = (f32x4){0.f, 0.f, 0.f, 0.f}; acc[0][0][0][1] = (f32x4){0.f, 0.f, 0.f, 0.f}; acc[0][1][0][0] = (f32x4){0.f, 0.f, 0.f, 0.f}; acc[0][1][0][1] = (f32x4){0.f, 0.f, 0.f, 0.f};
        for (int i = 0; i < PF && i < nt; ++i) PT_STAGE(i * SLOT, i);
        int so = 0, so2 = PF * SLOT;
        for (int kt = 0; kt < nt; ++kt) {
            const int ahead = nt - 1 - kt;
            if (ahead >= 4) asm volatile("s_waitcnt vmcnt(12)" ::: "memory"); else if (ahead == 3) asm volatile("s_waitcnt vmcnt(9)" ::: "memory");
            else if (ahead == 2) asm volatile("s_waitcnt vmcnt(6)" ::: "memory"); else if (ahead == 1) asm volatile("s_waitcnt vmcnt(3)" ::: "memory"); else asm volatile("s_waitcnt vmcnt(0)" ::: "memory");
            __builtin_amdgcn_s_barrier();
            if (kt + PF < nt) PT_STAGE(so2, kt + PF);
            bf16x8 At[2], B0[2][2], B1[2][2];
#pragma unroll
            for (int k = 0; k < 2; ++k) { At[k] = *(const LAS bf16x8*)(lds + so + aoff + k * 1024);
#pragma unroll
                for (int n = 0; n < 2; ++n) { B0[n][k] = *(const LAS bf16x8*)(lds + so + HTB + (2 * n + k) * 1024 + binner); B1[n][k] = *(const LAS bf16x8*)(lds + so + HTB + 4096 + (2 * n + k) * 1024 + binner); } }
#pragma unroll
            for (int k = 0; k < 2; ++k)
#pragma unroll
                for (int n = 0; n < 2; ++n) { acc[0][0][0][n] = __builtin_amdgcn_mfma_f32_16x16x32_bf16(B0[n][k], At[k], acc[0][0][0][n], 0, 0, 0);
                    acc[0][1][0][n] = __builtin_amdgcn_mfma_f32_16x16x32_bf16(B1[n][k], At[k], acc[0][1][0][n], 0, 0, 0); }
            so = (so == (NS - 1) * SLOT) ? 0 : so + SLOT; so2 = (so2 == (NS - 1) * SLOT) ? 0 : so2 + SLOT;
        }
        __builtin_amdgcn_s_barrier();
        E.template run<true>(acc, u, wr, wcq, fr, fq, sai, wm);
    }
#undef PT_DMA
#undef PT_STAGE
}
template <class Epi, bool ALIGN_EPI = false, bool SP2 = false, bool GATH = false>
__device__ __forceinline__ void gemm_run(LAS unsigned char* lds, const Gemm g, const StaticOrder& S, const Epi& E) { gemm_phase<Epi, ALIGN_EPI, SP2, GATH>(lds, g, S, E); gemm_tail<Epi, GATH>(lds, g, S, E); }
}
namespace epi {
using pg8::Unit;
typedef const f32x4 (&AccRef)[2][2][4][2];
__device__ __forceinline__ int vrow(int r) { return r < NLAT ? (r >> 14) : 2; }
__device__ __forceinline__ f32x4 bf4_f(unsigned lo, unsigned hi) { f32x4 r; r[0] = __uint_as_float(lo << 16); r[1] = __uint_as_float(lo & 0xffff0000u); r[2] = __uint_as_float(hi << 16); r[3] = __uint_as_float(hi & 0xffff0000u); return r; }
__device__ __forceinline__ void st_bf4(bf16_t* p, f32x4 v) { u32x2 w; w.x = cvtpk(v[0], v[1]); w.y = cvtpk(v[2], v[3]); *(u32x2*)p = w; }
__device__ __forceinline__ void rope4(f32x4& u1, f32x4& u2, const f32x2* rope, int ang, int i0) {
    const f32x4 cs0 = *(const f32x4*)(rope + ang * 16 + i0), cs1 = *(const f32x4*)(rope + ang * 16 + i0 + 2);
    const f32x4 c = {cs0[0], cs0[2], cs1[0], cs1[2]}, s = {cs0[1], cs0[3], cs1[1], cs1[3]};
    const f32x4 a = u1 * c - u2 * s, b = u2 * c + u1 * s; u1 = a; u2 = b;
}

__device__ __forceinline__ void vt_block(LAS unsigned char* scr, bf16_t* vt, const f32x4& ua, const f32x4& ub, int ca, int cb, int lane) {
    asm volatile("" : "+v"(lane));
    const bool odd = (lane & 1) != 0; const int fr = lane & 15, c0 = odd ? cb : ca;
    const f32x4 keep = odd ? ub : ua, send = odd ? ua : ub; f32x4 recv;
#pragma unroll
    for (int j = 0; j < 4; ++j) recv[j] = __shfl_xor(send[j], 1);
    const int fp = (fr & 2) | ((fr & 4) << 1) | ((fr & 8) >> 1);
#pragma unroll
    for (int j = 0; j < 4; ++j) *(LAS unsigned*)(scr + (c0 + j) * 32 + fp * 2) = odd ? cvtpk(recv[j], keep[j]) : cvtpk(keep[j], recv[j]);
    asm volatile("" ::: "memory");
    const u32x4 q = *(const LAS u32x4*)(scr + (lane >> 1) * 32 + (lane & 1) * 16);
    asm volatile("" ::: "memory");
    *(u32x4*)(vt + (size_t)(lane >> 1) * NROW + (lane & 1) * 8) = q;
}

struct EpiIn0 {
    static constexpr bool PERM = false;
    float* P; bf16_t* Q; bf16_t* K; bf16_t* V; const f32x2* rope; unsigned* kmax2; LAS unsigned char* scr;
    __device__ __forceinline__ void operator()(AccRef acc, const Unit& u, int wr, int wc, int fr, int fq) const { run<false>(acc, u, wr, wc, fr, fq, 0, 0); }
    template <bool SL> __device__ __forceinline__ void run(AccRef acc, const Unit& u, int wr, int wc, int fr, int fq, int sai, int sm) const {
        const int row0 = u.pm * 256 + wr * 64 + fr;
        if (u.pn == 0) {
#pragma unroll
            for (int ai = 0; ai < (SL ? 1 : 2); ++ai)
#pragma unroll
                for (int m = 0; m < (SL ? 1 : 4); ++m) { float* rowp = P + (size_t)(row0 + (SL ? sai : ai) * 128 + (SL ? sm : m) * 16) * 256 + wc * 32 + 4 * fq;
#pragma unroll
                    for (int bj = 0; bj < 2; ++bj)
#pragma unroll
                        for (int n = 0; n < 2; ++n) *(f32x4*)(rowp + bj * 128 + n * 16) = acc[ai][bj][m][n]; }
            return;
        }
        const int sec = (u.pn - 1) / 3, ct = (u.pn - 1) - sec * 3;
        if (sec == 2) {
            LAS unsigned char* ws_ = scr + (SL ? wr * 4 + sm : wr * 4 + wc) * 1024; const int lane = fq * 16 + fr;
#pragma unroll
            for (int ai = 0; ai < (SL ? 1 : 2); ++ai)
#pragma unroll
                for (int m = 0; m < (SL ? 1 : 4); ++m) { const int rb = row0 - fr + (SL ? sai : ai) * 128 + (SL ? sm : m) * 16;
#pragma unroll
                    for (int bj = 0; bj < 2; ++bj) vt_block(ws_, V + (size_t)((2 * ct + bj) * 128 + wc * 32) * NROW + rb, acc[ai][bj][m][0], acc[ai][bj][m][1], 4 * fq, 16 + 4 * fq, lane); }
            return;
        }
        bf16_t* base = Q + (size_t)sec * ((size_t)NROW * 768) + ct * 256 + wc * 32 + 8 * fq;
        const float sc = (sec == 0) ? QSC0 : 1.0f;
        const bool dorope = (sec < 2) && (u.pm < NLAT / 256);
        float kmx[2] = {0.f, 0.f};
#pragma unroll
        for (int ai = 0; ai < (SL ? 1 : 2); ++ai)
#pragma unroll
            for (int m = 0; m < (SL ? 1 : 4); ++m) { const int r = row0 + (SL ? sai : ai) * 128 + (SL ? sm : m) * 16; bf16_t* rowp = base + (size_t)r * 768;
                const int t = r & (SEQ - 1), ang = dorope ? ((wc & 1) ? (t & 63) : (t >> 6)) : 0;
#pragma unroll
                for (int bj = 0; bj < 2; ++bj) { f32x4 u1 = acc[ai][bj][m][0], u2 = acc[ai][bj][m][1];
                    rope4(u1, u2, rope, ang, 4 * fq);
                    if (sec == 1) { float s = ((u1[0] * u1[0] + u1[1] * u1[1]) + (u1[2] * u1[2] + u1[3] * u1[3])) + ((u2[0] * u2[0] + u2[1] * u2[1]) + (u2[2] * u2[2] + u2[3] * u2[3]));
                        s += __shfl_xor(s, 16); s += __shfl_xor(s, 32); kmx[bj] = fmaxf(kmx[bj], s); }
                    { const f32x4 y1 = u1 * sc, y2 = u2 * sc; u32x4 w; w.x = cvtpk(y1[0], y1[1]); w.y = cvtpk(y1[2], y1[3]); w.z = cvtpk(y2[0], y2[1]); w.w = cvtpk(y2[2], y2[3]); *(u32x4*)(rowp + bj * 128) = w; } } if (m == 3) asm volatile("" ::: "memory"); }
        if (sec == 1) { const int b = u.pm < NLAT / 256 ? (u.pm >> 6) : (u.pm - NLAT / 256);
#pragma unroll
            for (int bj = 0; bj < 2; ++bj) { float s = kmx[bj];
#pragma unroll
                for (int o = 1; o < 16; o <<= 1) s = fmaxf(s, __shfl_xor(s, o));
                if (fr == 0 && fq == 0) atomicMax(kmax2 + (((b * 6 + 2 * ct + bj) * 2 + (wc >> 1)) * 2 + (wc & 1)), __float_as_uint(s)); } }
    }
};
template <bool BIN>
struct EpiRes {
    static constexpr bool PERM = true;
    const void* baseL; bf16_t* outL; const void* baseC; bf16_t* outC; const float* gate;
    __device__ __forceinline__ void operator()(AccRef acc, const Unit& u, int wr, int wc, int fr, int fq) const { run<false>(acc, u, wr, wc, fr, fq, 0, 0); }
    template <bool SL> __device__ __forceinline__ void run(AccRef acc, const Unit& u, int wr, int wc, int fr, int fq, int sai, int sm) const {
        const bool lat = u.pm < NLAT / 256;
        const int rbase = lat ? 0 : NLAT;
        const GAS char* bp = (const GAS char*)(lat ? baseL : baseC); GAS bf16_t* op = (GAS bf16_t*)(lat ? outL : outC);
        const int v = lat ? (u.pm >> 6) : 2;
        const int col0 = u.pn * 256 + wc * 32 + 8 * fq, row0 = u.pm * 256 - rbase + wr * 64 + fr;
        constexpr int NA = SL ? 1 : 2, NM = SL ? 1 : 4;
        f32x4 gv[2][2];
#pragma unroll
        for (int bj = 0; bj < 2; ++bj)
#pragma unroll
            for (int n = 0; n < 2; ++n) gv[bj][n] = *(const GAS f32x4*)((const GAS float*)gate + v * NMOD + col0 + bj * 128 + 4 * n);
        if constexpr (BIN) {
#pragma unroll
            for (int ai = 0; ai < NA; ++ai) { u32x4 w[NM][2];
#pragma unroll
                for (int m = 0; m < NM; ++m) { const size_t off = (size_t)(row0 + (SL ? sai : ai) * 128 + (SL ? sm : m) * 16) * D + col0;
#pragma unroll
                    for (int bj = 0; bj < 2; ++bj) w[m][bj] = *(const GAS u32x4*)(bp + (off + bj * 128) * 2); }
#pragma unroll
                for (int m = 0; m < NM; ++m) { const size_t off = (size_t)(row0 + (SL ? sai : ai) * 128 + (SL ? sm : m) * 16) * D + col0;
#pragma unroll
                    for (int bj = 0; bj < 2; ++bj) { const u32x4 x = w[m][bj];
                        const f32x4 r0 = bf4_f(x.x, x.y) + gv[bj][0] * acc[ai][bj][m][0], r1 = bf4_f(x.z, x.w) + gv[bj][1] * acc[ai][bj][m][1];
                        u32x4 o; o.x = cvtpk(r0[0], r0[1]); o.y = cvtpk(r0[2], r0[3]); o.z = cvtpk(r1[0], r1[1]); o.w = cvtpk(r1[2], r1[3]);
                        *(GAS u32x4*)(op + off + bj * 128) = o; } }
                asm volatile("" ::: "memory"); }
        } else {
#pragma unroll
            for (int ai = 0; ai < NA; ++ai) { f32x4 b[NM][2][2];
#pragma unroll
                for (int m = 0; m < NM; ++m) { const size_t off = (size_t)(row0 + (SL ? sai : ai) * 128 + (SL ? sm : m) * 16) * D + col0;
#pragma unroll
                    for (int bj = 0; bj < 2; ++bj) { b[m][bj][0] = *(const GAS f32x4*)(bp + (off + bj * 128) * 4); b[m][bj][1] = *(const GAS f32x4*)(bp + (off + bj * 128 + 4) * 4); } }
#pragma unroll
                for (int m = 0; m < NM; ++m) { const size_t off = (size_t)(row0 + (SL ? sai : ai) * 128 + (SL ? sm : m) * 16) * D + col0;
#pragma unroll
                    for (int bj = 0; bj < 2; ++bj) { const f32x4 r0 = b[m][bj][0] + gv[bj][0] * acc[ai][bj][m][0], r1 = b[m][bj][1] + gv[bj][1] * acc[ai][bj][m][1];
                        u32x4 o; o.x = cvtpk(r0[0], r0[1]); o.y = cvtpk(r0[2], r0[3]); o.z = cvtpk(r1[0], r1[1]); o.w = cvtpk(r1[2], r1[3]);
                        *(GAS u32x4*)(op + off + bj * 128) = o; } }
                asm volatile("" ::: "memory"); }
        }
    }
};
__device__ __forceinline__ float silu_f(float x) { return x * __builtin_amdgcn_rcpf(1.0f + __builtin_amdgcn_exp2f(-x * LOG2E)); }
struct EpiGU {
    static constexpr bool PERM = true;
    bf16_t* H;
    __device__ __forceinline__ void operator()(AccRef acc, const Unit& u, int wr, int wc, int fr, int fq) const { run<false>(acc, u, wr, wc, fr, fq, 0, 0); }
    template <bool SL> __device__ __forceinline__ void run(AccRef acc, const Unit& u, int wr, int wc, int fr, int fq, int sai, int sm) const {
        const int row0 = u.pm * 256 + wr * 64 + fr, col0 = u.pn * 128 + wc * 32 + 8 * fq;
#pragma unroll
        for (int ai = 0; ai < (SL ? 1 : 2); ++ai)
#pragma unroll
            for (int m = 0; m < (SL ? 1 : 4); ++m) { bf16_t* rowp = H + (size_t)(row0 + (SL ? sai : ai) * 128 + (SL ? sm : m) * 16) * FF + col0;
                f32x4 h0, h1;
#pragma unroll
                for (int j = 0; j < 4; ++j) { h0[j] = silu_f(acc[ai][0][m][0][j]) * acc[ai][1][m][0][j]; h1[j] = silu_f(acc[ai][0][m][1][j]) * acc[ai][1][m][1][j]; }
                u32x4 w; w.x = cvtpk(h0[0], h0[1]); w.y = cvtpk(h0[2], h0[3]); w.z = cvtpk(h1[0], h1[1]); w.w = cvtpk(h1[2], h1[3]);
                *(u32x4*)rowp = w; }
    }
};
struct EpiIn1 {
    static constexpr bool PERM = false;
    bf16_t* CQ; bf16_t* CKV; bf16_t* KR; float* ssq_q; float* ssq_kv; const f32x2* rope; unsigned* krmax2;
    __device__ __forceinline__ void operator()(AccRef acc, const Unit& u, int wr, int wc, int fr, int fq) const { run<false>(acc, u, wr, wc, fr, fq, 0, 0); }
    template <bool SL> __device__ __forceinline__ void run(AccRef acc, const Unit& u, int wr, int wc, int fr, int fq, int sai, int sm) const {
        const int row0 = u.pm * 256 + wr * 64 + fr;
        if (u.pn < 3) {
            bf16_t* base = (u.pn < 2) ? (CQ + u.pn * 256) : CKV; const int ld = (u.pn < 2) ? 512 : 256; float* ssq = (u.pn < 2) ? ssq_q : ssq_kv;
#pragma unroll
            for (int ai = 0; ai < (SL ? 1 : 2); ++ai)
#pragma unroll
                for (int m = 0; m < (SL ? 1 : 4); ++m) { const int r = row0 + (SL ? sai : ai) * 128 + (SL ? sm : m) * 16; bf16_t* rowp = base + (size_t)r * ld + wc * 32 + 4 * fq; float s = 0.f;
#pragma unroll
                    for (int bj = 0; bj < 2; ++bj)
#pragma unroll
                        for (int n = 0; n < 2; ++n) { const f32x4 x = acc[ai][bj][m][n]; s += (x[0] * x[0] + x[1] * x[1]) + (x[2] * x[2] + x[3] * x[3]); st_bf4(rowp + bj * 128 + n * 16, x); }
                    s += __shfl_xor(s, 16); s += __shfl_xor(s, 32);
                    if (fq == 0) atomicAdd(ssq + r, s); }
        } else if (wc < 2) {
            const bool dorope = u.pm < NLAT / 256; float kmx = 0.f;
#pragma unroll
            for (int ai = 0; ai < (SL ? 1 : 2); ++ai)
#pragma unroll
                for (int m = 0; m < (SL ? 1 : 4); ++m) { const int r = row0 + (SL ? sai : ai) * 128 + (SL ? sm : m) * 16; const int t = r & (SEQ - 1), ang = dorope ? ((wc & 1) ? (t & 63) : (t >> 6)) : 0;
                    f32x4 u1 = acc[ai][0][m][0], u2 = acc[ai][0][m][1];
                    rope4(u1, u2, rope, ang, 4 * fq);
                    { float s = ((u1[0] * u1[0] + u1[1] * u1[1]) + (u1[2] * u1[2] + u1[3] * u1[3])) + ((u2[0] * u2[0] + u2[1] * u2[1]) + (u2[2] * u2[2] + u2[3] * u2[3]));
                      s += __shfl_xor(s, 16); s += __shfl_xor(s, 32); kmx = fmaxf(kmx, s); }
                    bf16_t* rowp = KR + (size_t)r * 64 + wc * 32 + 4 * fq; st_bf4(rowp, u1); st_bf4(rowp + 16, u2); }
            { const int b = u.pm < NLAT / 256 ? (u.pm >> 6) : (u.pm - NLAT / 256);
#pragma unroll
              for (int o = 1; o < 16; o <<= 1) kmx = fmaxf(kmx, __shfl_xor(kmx, o));
              if (fr == 0 && fq == 0) atomicMax(krmax2 + b * 2 + wc, __float_as_uint(kmx)); }
        }
    }
};
struct EpiUQ {
    static constexpr bool PERM = false;
    bf16_t* Q1; const float* ssq_q; const f32x2* rope;
    __device__ __forceinline__ void operator()(AccRef acc, const Unit& u, int wr, int wc, int fr, int fq) const { run<false>(acc, u, wr, wc, fr, fq, 0, 0); }
    template <bool SL> __device__ __forceinline__ void run(AccRef acc, const Unit& u, int wr, int wc, int fr, int fq, int sai, int sm) const {
        const int row0 = u.pm * 256 + wr * 64 + fr;
#pragma unroll
        for (int ai = 0; ai < (SL ? 1 : 2); ++ai)
#pragma unroll
            for (int m = 0; m < (SL ? 1 : 4); ++m) { const int r = row0 + (SL ? sai : ai) * 128 + (SL ? sm : m) * 16; const int t = r & (SEQ - 1), ang = (wc & 1) ? (t & 63) : (t >> 6);
                const float rs = QSC1 / sqrtf(ssq_q[r] * (1.0f / 512.0f) + EPS);
                bf16_t* rowp = Q1 + (size_t)r * 1536 + u.pn * 256 + wc * 32 + 4 * fq;
#pragma unroll
                for (int bj = 0; bj < 2; ++bj) { f32x4 u1 = acc[ai][bj][m][0], u2 = acc[ai][bj][m][1];
                    const int b64 = 4 * u.pn + 2 * bj + (wc >> 1);
                    rope4(u1, u2, rope, (b64 % 3 == 2) ? ang : 0, 4 * fq);
                    st_bf4(rowp + bj * 128, u1 * rs); st_bf4(rowp + bj * 128 + 16, u2 * rs); } if (m == 3) asm volatile("" ::: "memory"); }
    }
};
struct EpiUKV {
    static constexpr bool PERM = true;
    bf16_t* KV1; const float* ssq_kv; unsigned* knmax2;
    bf16_t* VT1;
    LAS unsigned char* scr;
    __device__ __forceinline__ void operator()(AccRef acc, const Unit& u, int wr, int wc, int fr, int fq) const { run<false>(acc, u, wr, wc, fr, fq, 0, 0); }
    template <bool SL> __device__ __forceinline__ void run(AccRef acc, const Unit& u, int wr, int wc, int fr, int fq, int sai, int sm) const {
        const int row0 = u.pm * 256 + wr * 64 + fr, col0 = u.pn * 256 + wc * 32 + 8 * fq; float kmx = 0.f;
#pragma unroll
        for (int ai = 0; ai < (SL ? 1 : 2); ++ai)
#pragma unroll
            for (int m = 0; m < (SL ? 1 : 4); ++m) { const int r = row0 + (SL ? sai : ai) * 128 + (SL ? sm : m) * 16; const float rs = 1.0f / sqrtf(ssq_kv[r] * (1.0f / 256.0f) + EPS);
                bf16_t* rowp = KV1 + (size_t)r * 2048 + col0;
#pragma unroll
                for (int bj = 0; bj < 2; ++bj) { const f32x4 v0 = acc[ai][bj][m][0] * rs, v1 = acc[ai][bj][m][1] * rs;
                    if (bj == 0) { float s = ((v0[0] * v0[0] + v0[1] * v0[1]) + (v0[2] * v0[2] + v0[3] * v0[3])) + ((v1[0] * v1[0] + v1[1] * v1[1]) + (v1[2] * v1[2] + v1[3] * v1[3]));
                        s += __shfl_xor(s, 16); s += __shfl_xor(s, 32); kmx = fmaxf(kmx, s); }
                    if (bj == 0) { u32x4 w; w.x = cvtpk(v0[0], v0[1]); w.y = cvtpk(v0[2], v0[3]); w.z = cvtpk(v1[0], v1[1]); w.w = cvtpk(v1[2], v1[3]);
                        *(u32x4*)rowp = w; }
                    else vt_block(scr + (SL ? wr * 4 + sm : wr * 4 + wc) * 1024, VT1 + (size_t)(u.pn * 128 + wc * 32) * NROW + (r - fr), v0, v1, 8 * fq, 8 * fq + 4, fq * 16 + fr); } asm volatile("" ::: "memory"); }
        { const int b = u.pm < NLAT / 256 ? (u.pm >> 6) : (u.pm - NLAT / 256);
#pragma unroll
          for (int o = 1; o < 16; o <<= 1) kmx = fmaxf(kmx, __shfl_xor(kmx, o));
          if (fr == 0 && fq == 0) atomicMax(knmax2 + (b * 8 + u.pn) * 4 + wc, __float_as_uint(kmx)); }
    }
};
struct EpiMoeDown {
    static constexpr bool PERM = true;
    const bf16_t* src; bf16_t* dst; const float* g2;
    const int* idx; const float* wgt;
    const volatile LAS int* pb; const volatile LAS int* cnt;
    __device__ __forceinline__ void operator()(AccRef acc, const Unit& u, int wr, int wc, int fr, int fq) const { run<false>(acc, u, wr, wc, fr, fq, 0, 0); }
    template <bool SL> __device__ __forceinline__ void run(AccRef acc, const Unit& u, int wr, int wc, int fr, int fq, int sai, int sm) const {
        int e = 0;
#pragma unroll
        for (int k = 1; k < 8; ++k) e += (u.pm >= pb[k]) ? 1 : 0;
        const int lp = u.pm - pb[e], n_e = cnt[e];
        const int col0 = u.pn * 256 + wc * 32 + 8 * fq;
        int tok[8]; float wv[8];
#pragma unroll
        for (int g = 0; g < (SL ? 1 : 8); ++g) { const int pos = lp * 256 + (SL ? sai : (g >> 2)) * 128 + wr * 64 + (SL ? sm : (g & 3)) * 16 + fr; const bool ok = pos < n_e;
            tok[g] = ok ? idx[e * NLAT + pos] : -1; wv[g] = ok ? wgt[e * NLAT + pos] : 0.f; }
#pragma unroll
        for (int ai = 0; ai < (SL ? 1 : 2); ++ai)
#pragma unroll
            for (int m = 0; m < (SL ? 1 : 4); ++m) { const int t = tok[ai * 4 + m];
                if (t >= 0) { const float w = wv[ai * 4 + m]; const bf16_t* ip = src + (size_t)t * D + col0; bf16_t* op = dst + (size_t)t * D + col0; const float* gp = g2 + (t >> 14) * NMOD + col0;
#pragma unroll
                    for (int bj = 0; bj < 2; ++bj) { const u32x4 x = *(const u32x4*)(ip + bj * 128); const f32x4 ga = *(const f32x4*)(gp + bj * 128), gb = *(const f32x4*)(gp + bj * 128 + 4);
                        const f32x4 r0 = bf4_f(x.x, x.y) + ga * w * acc[ai][bj][m][0], r1 = bf4_f(x.z, x.w) + gb * w * acc[ai][bj][m][1];
                        u32x4 o; o.x = cvtpk(r0[0], r0[1]); o.y = cvtpk(r0[2], r0[3]); o.z = cvtpk(r1[0], r1[1]); o.w = cvtpk(r1[2], r1[3]);
                        *(u32x4*)(op + bj * 128) = o; } } if (m & 1) asm volatile("" ::: "memory"); }
    }
};
}
namespace att {
constexpr int KVBLK = 64;
constexpr float THRL = 11.5416f;
constexpr int VROW = 144, SHM_V = 128 * VROW;
template <int MODE> struct Cfg;
#ifndef ATT0_LSUM
#define ATT0_LSUM 0
#endif
constexpr int KROW_N = 272, KROW_R = 144, KIMG_N = 64 * KROW_N  , KIMG_R = 64 * KROW_R  ;
template <> struct Cfg<0> { static constexpr bool LSUM = ATT0_LSUM; static constexpr int NQ = 4, NQR = 4, SHM_K = KIMG_N, KRING = 3, PF = 2  ; };
#ifndef ATT1_NQR
#define ATT1_NQR 6
#endif
template <> struct Cfg<1> { static constexpr int NQ = 12, NQR = ATT1_NQR  , SHM_K = KIMG_N + KIMG_R, KRING = 2, PF = 2; static constexpr bool LSUM = false; };
#define SBAR() __builtin_amdgcn_sched_barrier(0)
#ifndef SGB_VALU
#define SGB_VALU 4
#endif
#define SGB_PIPE() do { _Pragma("unroll") for (int _g = 0; _g < 24; ++_g) { __builtin_amdgcn_sched_group_barrier(0x8, 1, 0); __builtin_amdgcn_sched_group_barrier(0x402, SGB_VALU, 0); __builtin_amdgcn_sched_group_barrier(0x100, 2, 0); } } while (0)
__device__ __forceinline__ int crow(int r, int hi) { return (r & 3) + 8 * (r >> 2) + 4 * hi; }
template <int VAR = 0, bool LSUM = false> __device__ __forceinline__ void expA(f32x16& p0, float& l_reg) {
#ifdef ATT_PRIO_EXP
    __builtin_amdgcn_s_setprio(1);
#endif
    if constexpr (VAR != 1) {
#pragma unroll
    for (int r = 0; r < 16; ++r) p0[r] = __builtin_amdgcn_exp2f(p0[r]); }
    if constexpr (!LSUM) { float ps = 0;
#pragma unroll
    for (int r = 0; r < 16; ++r) ps += p0[r];
    l_reg += ps; }
#ifdef ATT_PRIO_EXP
    __builtin_amdgcn_s_setprio(0);
#endif
}
template <int MODE> struct QkFrag { bf16x8 b0, b1, q; };
template <int MODE> __device__ __forceinline__ void qk_load(QkFrag<MODE>& f, int d0, const char* Ks, const bf16x8* qr, const char* qrl, int kn, int kr) {
    if (MODE == 0 || d0 < 8) { f.b0 = *reinterpret_cast<const bf16x8*>(Ks + kn + d0 * 32); f.b1 = *reinterpret_cast<const bf16x8*>(Ks + kn + 32 * KROW_N + d0 * 32); }
    else { f.b0 = *reinterpret_cast<const bf16x8*>(Ks + KIMG_N + kr + (d0 - 8) * 32); f.b1 = *reinterpret_cast<const bf16x8*>(Ks + KIMG_N + kr + 32 * KROW_R + (d0 - 8) * 32); }
    if constexpr (MODE == 1) { if (d0 >= Cfg<1>::NQR) f.q = *reinterpret_cast<const bf16x8*>(qrl + (d0 - Cfg<1>::NQR) * 1024); else f.q = qr[d0]; } else f.q = qr[d0];
}
template <int MODE> __device__ __forceinline__ void qk_pre(QkFrag<MODE>* f, const char* Ks, const bf16x8* qr, const char* qrl, int kn, int kr) {
#pragma unroll
    for (int d0 = 0; d0 < Cfg<MODE>::PF; ++d0) qk_load<MODE>(f[d0], d0, Ks, qr, qrl, kn, kr);
}
template <int MODE> __device__ __forceinline__ void qk_run(f32x16& p0, f32x16& p1, const f32x16& cm, QkFrag<MODE>* f, const char* Ks, const bf16x8* qr, const char* qrl, int kn, int kr) {
    constexpr int NQ = Cfg<MODE>::NQ, PF = Cfg<MODE>::PF;
#pragma unroll
    for (int d0 = 0; d0 < NQ; ++d0) {
        if (d0 + PF < NQ) qk_load<MODE>(f[d0 + PF], d0 + PF, Ks, qr, qrl, kn, kr);
        __builtin_amdgcn_sched_barrier(0x406);
        if (d0 == 0) { p0 = __builtin_amdgcn_mfma_f32_32x32x16_bf16(f[0].b0, f[0].q, cm, 0, 0, 0); p1 = __builtin_amdgcn_mfma_f32_32x32x16_bf16(f[0].b1, f[0].q, cm, 0, 0, 0); }
        else { p0 = __builtin_amdgcn_mfma_f32_32x32x16_bf16(f[d0].b0, f[d0].q, p0, 0, 0, 0); p1 = __builtin_amdgcn_mfma_f32_32x32x16_bf16(f[d0].b1, f[d0].q, p1, 0, 0, 0); }
        __builtin_amdgcn_sched_barrier(0x406);
    }
}
template <int MODE> __device__ __forceinline__ void qkt(f32x16& p0, f32x16& p1, const f32x16& cm, const char* Ks, const bf16x8* qr, const char* qrl, int kn, int kr) {
    QkFrag<MODE> f[Cfg<MODE>::NQ]; qk_pre<MODE>(f, Ks, qr, qrl, kn, kr); qk_run<MODE>(p0, p1, cm, f, Ks, qr, qrl, kn, kr);
}
__device__ __forceinline__ int v_st(int k, int c) { const int kk = (k & ~0xC) | ((k & 4) << 1) | ((k & 8) >> 1); return ((kk >> 3) * 4 + (c >> 5)) * 512 + ((kk & 7) * 32 + (c & 31)) * 2; }
__device__ __forceinline__ int v_rd_base(int lane) { return ((lane & 3) << 3) | (((lane >> 2) & 3) << 6) | (((lane >> 4) & 1) << 5) | (((lane >> 5) & 1) << 8); }
constexpr int v_rd_off(int d0, int ks, int half) { return d0 * 512 + ks * 4096 + half * 2048; }
template <int OFF> __device__ __forceinline__ s16x4 tr_read(int vb) {
    s16x4 r; asm volatile("ds_read_b64_tr_b16 %0, %1 offset:%2" : "=&v"(r) : "v"(vb), "i"(OFF) : "memory"); return r;
}
template <int KS, int VAR = 0, bool LSUM = false> __device__ __forceinline__ void pv_ks(f32x16* o, const char* vp, const f32x16& p) {
    static_assert(!LSUM, "row sums by MFMA are not available in the transposed form");
    constexpr int B = 8 * (KS & 1);
    const bf16x8 v0 = *reinterpret_cast<const bf16x8*>(vp + 0 * 32 * VROW + KS * 32), v1 = *reinterpret_cast<const bf16x8*>(vp + 1 * 32 * VROW + KS * 32);
    const bf16x8 v2 = *reinterpret_cast<const bf16x8*>(vp + 2 * 32 * VROW + KS * 32), v3 = *reinterpret_cast<const bf16x8*>(vp + 3 * 32 * VROW + KS * 32);
    bf16x8 pb;
    { u32x4 w = {cvtpk(p[B + 0], p[B + 1]), cvtpk(p[B + 2], p[B + 3]), cvtpk(p[B + 4], p[B + 5]), cvtpk(p[B + 6], p[B + 7])}; pb = *reinterpret_cast<bf16x8*>(&w); }
    if constexpr (VAR == 6) { asm volatile("" :: "v"(pb), "v"(v0), "v"(v1), "v"(v2), "v"(v3)); } else {
    o[0] = __builtin_amdgcn_mfma_f32_32x32x16_bf16(v0, pb, o[0], 0, 0, 0);
    o[1] = __builtin_amdgcn_mfma_f32_32x32x16_bf16(v1, pb, o[1], 0, 0, 0);
    o[2] = __builtin_amdgcn_mfma_f32_32x32x16_bf16(v2, pb, o[2], 0, 0, 0);
    o[3] = __builtin_amdgcn_mfma_f32_32x32x16_bf16(v3, pb, o[3], 0, 0, 0); }
}
template <int VAR = 0, bool LSUM = false> __device__ __forceinline__ void pv_all(f32x16* o, const char* vp, const f32x16& p0, const f32x16& p1) {
    pv_ks<0, VAR, LSUM>(o, vp, p0); pv_ks<1, VAR, LSUM>(o, vp, p0); pv_ks<2, VAR, LSUM>(o, vp, p1); pv_ks<3, VAR, LSUM>(o, vp, p1);
}

template <int VAR = 0> __device__ __forceinline__ void pv_all_pre(f32x16* o, const char* vp, const f32x16& p0, const f32x16& p1, const bf16x8 (&vf)[4]) {
    bf16x8 pb;
    { u32x4 w = {cvtpk(p0[0], p0[1]), cvtpk(p0[2], p0[3]), cvtpk(p0[4], p0[5]), cvtpk(p0[6], p0[7])}; pb = *reinterpret_cast<bf16x8*>(&w); }
#pragma unroll
    for (int d = 0; d < 4; ++d) o[d] = __builtin_amdgcn_mfma_f32_32x32x16_bf16(vf[d], pb, o[d], 0, 0, 0);
    pv_ks<1, VAR, false>(o, vp, p0); pv_ks<2, VAR, false>(o, vp, p1); pv_ks<3, VAR, false>(o, vp, p1);
}
#define ATT_VPRE(vf, vp) do { _Pragma("unroll") for (int _d = 0; _d < 4; ++_d) (vf)[_d] = *reinterpret_cast<const bf16x8*>((vp) + _d * 32 * VROW); } while (0)
template <int MODE, int VAR = 0>
__device__ __forceinline__ void attn_unit(const bf16_t* __restrict__ Qw, const bf16_t* __restrict__ Kg, const bf16_t* __restrict__ Vg, const bf16_t* __restrict__ KRg,
                                          int lat0, int nlt, int ctx0, int NT, bf16_t* __restrict__ Od, int orow0, float lam, const float* __restrict__ kb2, const float* __restrict__ kb2r,
                                          char* lds, LAS unsigned char* ldsl) {
    using C = Cfg<MODE>; constexpr int NQ = C::NQ, SHM_K = C::SHM_K;
    const int tid = opaque_tid(), wid = tid >> 6, lane = tid & 63, r32 = lane & 31, hi = lane >> 5;
    const int wu = __builtin_amdgcn_readfirstlane(wid);
    constexpr int VRING = C::KRING;
    char* V_lds = lds; char* K_lds = lds + VRING * SHM_V;
    constexpr int KRING = C::KRING;
    float* ws = (float*)(lds + VRING * SHM_V + KRING * SHM_K) + wid * 64; float* li_l = ws;
    float l_reg = 0; f32x16 o[4] = {}; bf16x8 qr[C::NQR];
    char* qrl = lds + VRING * SHM_V + KRING * SHM_K + 2048 + (wid * (NQ - C::NQR) * 64 + lane) * 16;
    float mrow = 0.f;
#pragma unroll
    for (int blk = 0; blk < NQ / 2; ++blk) { float s2 = 0.f;
#pragma unroll
        for (int dd = 0; dd < 2; ++dd) { const int d0 = 2 * blk + dd; const bf16x8 q = *reinterpret_cast<const bf16x8*>(Qw + d0 * 16);
#pragma unroll
            for (int j = 0; j < 8; ++j) { const float x = __uint_as_float(((unsigned)(unsigned short)q[j]) << 16); s2 += x * x; }
            if constexpr (MODE == 1) { if (d0 >= C::NQR) *reinterpret_cast<bf16x8*>(qrl + (d0 - C::NQR) * 1024) = q; else qr[d0] = q; } else qr[d0] = q; }
        s2 += __shfl_xor(s2, 32);
        float k2;
        if constexpr (MODE == 0) k2 = kb2[(wid >> 2) * 2 + blk]; else k2 = (blk < 4) ? kb2[blk] : kb2r[blk - 4];
        mrow += sqrtf(s2 * k2); }
    mrow = mrow * 1.01f + 1e-3f;
    f32x16 cm;
#pragma unroll
    for (int r = 0; r < 16; ++r) cm[r] = -mrow;
    const int kn = r32 * KROW_N + ((MODE == 0) ? (wid >> 2) * 128 : 0) + hi * 16, kr = r32 * KROW_R + hi * 16;
    const char* vp0 = V_lds + r32 * VROW + hi * 16;
    constexpr int KSTR = (MODE == 0) ? 768 : 2048;
    unsigned vsrc[3], ksrc[3], rsrc[2] = {0u, 0u};
#pragma unroll
    for (int i = 0; i < 3; ++i) { const int L = 1024 * (wid + 8 * i) + 16 * lane, col = (L / VROW) & 127, x = L - (L / VROW) * VROW; vsrc[i] = (unsigned)col * (unsigned)(NROW * 2) + (unsigned)(x < 128 ? x : 0); }
#pragma unroll
    for (int i = 0; i < 3; ++i) { const int L = 1024 * (wid + 8 * i) + 16 * lane, row = (L / KROW_N) & 63, x = L - (L / KROW_N) * KROW_N; ksrc[i] = (unsigned)(row * KSTR) * 2u + (unsigned)(x < 256 ? x : 0); }
    if constexpr (MODE == 1) {
#pragma unroll
        for (int i = 0; i < 2; ++i) { const int L = 1024 * (wid + 8 * i) + 16 * lane, row = (L / KROW_R) & 63, x = L - (L / KROW_R) * KROW_R; rsrc[i] = (unsigned)(row * 64) * 2u + (unsigned)(x < 128 ? x : 0); } }
    const unsigned pw = 1024u * (unsigned)wu;
#define TROW(j) ((j) < nlt ? lat0 + (j) * KVBLK : ctx0 + ((j) - nlt) * KVBLK)
#define DMA16(gp, loff) if constexpr (VAR != 3) __builtin_amdgcn_global_load_lds((const unsigned*)(gp), (LAS unsigned*)(ldsl + (loff)), 16, 0, 0)
#define LOADK(j, koff) do { const size_t _r = (size_t)TROW(j); const char* _kb = (const char*)(Kg + _r * KSTR); const unsigned _kl = VRING * SHM_V + (unsigned)(koff); \
    DMA16(_kb + ksrc[0], _kl + pw); DMA16(_kb + ksrc[1], _kl + 8192 + pw); if (wu == 0) DMA16(_kb + ksrc[2], _kl + 16384); \
    if constexpr (MODE == 1) { const char* _rb = (const char*)(KRg + _r * 64); DMA16(_rb + rsrc[0], _kl + KIMG_N + pw); if (wu == 0) DMA16(_rb + rsrc[1], _kl + KIMG_N + 8192); } } while (0)
#define LOADV(j, voff) do { const char* _vb = (const char*)Vg + (size_t)TROW(j) * 2; \
    DMA16(_vb + vsrc[0], (unsigned)(voff) + pw); DMA16(_vb + vsrc[1], (unsigned)(voff) + 8192 + pw); if (wu < 2) DMA16(_vb + vsrc[2], (unsigned)(voff) + 16384 + pw); } while (0)
#define SYNC() do { asm volatile("s_waitcnt vmcnt(0) lgkmcnt(0)" ::: "memory"); if constexpr (VAR != 2) __builtin_amdgcn_s_barrier(); asm volatile("" ::: "memory"); } while (0)
#define SYNCK() do { if constexpr (KRING == 3) { if constexpr (MODE == 0) asm volatile("s_waitcnt vmcnt(4) lgkmcnt(0)" ::: "memory"); else asm volatile("s_waitcnt vmcnt(5) lgkmcnt(0)" ::: "memory"); } \
    else asm volatile("s_waitcnt vmcnt(0) lgkmcnt(0)" ::: "memory"); if constexpr (VAR != 2) __builtin_amdgcn_s_barrier(); asm volatile("" ::: "memory"); } while (0)
    f32x16 pA0, pA1, pB0, pB1;
    if constexpr (KRING == 2) {
    LOADK(0, 0); LOADV(0, 0); LOADK(1, SHM_K); SYNC();
    if constexpr (VAR != 5) qkt<MODE>(pA0, pA1, cm, K_lds, qr, qrl, kn, kr); expA<VAR, C::LSUM>(pA0, l_reg); SYNC();
    for (int j = 0; j + 2 < NT; j += 2) {
        LOADK(j + 2, 0); LOADV(j + 1, SHM_V);
        { QkFrag<MODE> kf[NQ]; SBAR(); if constexpr (VAR != 5) qk_pre<MODE>(kf, K_lds + SHM_K, qr, qrl, kn, kr); SBAR(); expA<VAR, C::LSUM>(pA1, l_reg); if constexpr (VAR != 5) qk_run<MODE>(pB0, pB1, cm, kf, K_lds + SHM_K, qr, qrl, kn, kr); SBAR(); }
        if constexpr (VAR != 4) pv_all<VAR, C::LSUM>(o, vp0, pA0, pA1); expA<VAR, C::LSUM>(pB0, l_reg);
        SYNC();
        LOADK(j + 3, SHM_K); LOADV(j + 2, 0);
        { QkFrag<MODE> kf[NQ]; SBAR(); if constexpr (VAR != 5) qk_pre<MODE>(kf, K_lds, qr, qrl, kn, kr); SBAR(); expA<VAR, C::LSUM>(pB1, l_reg); if constexpr (VAR != 5) qk_run<MODE>(pA0, pA1, cm, kf, K_lds, qr, qrl, kn, kr); SBAR(); }
        if constexpr (VAR != 4) pv_all<VAR, C::LSUM>(o, vp0 + SHM_V, pB0, pB1); expA<VAR, C::LSUM>(pA0, l_reg);
        SYNC();
    }
    LOADV(NT - 1, SHM_V);
    { QkFrag<MODE> kf[NQ]; SBAR(); if constexpr (VAR != 5) qk_pre<MODE>(kf, K_lds + SHM_K, qr, qrl, kn, kr); SBAR(); expA<VAR, C::LSUM>(pA1, l_reg); if constexpr (VAR != 5) qk_run<MODE>(pB0, pB1, cm, kf, K_lds + SHM_K, qr, qrl, kn, kr); SBAR(); }
    if constexpr (VAR != 4) pv_all<VAR, C::LSUM>(o, vp0, pA0, pA1); expA<VAR, C::LSUM>(pB0, l_reg);
    SYNC();
    expA<VAR, C::LSUM>(pB1, l_reg);
    if constexpr (VAR != 4) pv_all<VAR, C::LSUM>(o, vp0 + SHM_V, pB0, pB1);
    } else {
    LOADK(0, 0); LOADV(0, 0); LOADK(1, SHM_K); LOADV(1, SHM_V); LOADK(2, 2 * SHM_K); SYNC();
    if constexpr (VAR != 5) qkt<MODE>(pA0, pA1, cm, K_lds, qr, qrl, kn, kr); expA<VAR, C::LSUM>(pA0, l_reg); SYNC();
    int k0 = 0, k1 = SHM_K, k2 = 2 * SHM_K;
    int v0 = 0, v1 = SHM_V, v2 = 2 * SHM_V;
    for (int j = 0; j + 2 < NT; j += 2) {
        LOADV(j + 2, v2); LOADK((j + 3 < NT) ? j + 3 : NT - 1, k0);
        { QkFrag<MODE> kf[NQ]; bf16x8 vf[4]; SBAR(); if constexpr (VAR != 5) qk_pre<MODE>(kf, K_lds + k1, qr, qrl, kn, kr); ATT_VPRE(vf, vp0 + v0); SBAR(); expA<VAR, C::LSUM>(pA1, l_reg); if constexpr (VAR != 5) qk_run<MODE>(pB0, pB1, cm, kf, K_lds + k1, qr, qrl, kn, kr); SBAR();
          if constexpr (VAR != 4) pv_all_pre<VAR>(o, vp0 + v0, pA0, pA1, vf); } expA<VAR, C::LSUM>(pB0, l_reg);
        SYNCK();
        LOADV((j + 3 < NT) ? j + 3 : NT - 1, v0); LOADK((j + 4 < NT) ? j + 4 : NT - 1, k1);
        { QkFrag<MODE> kf[NQ]; bf16x8 vf[4]; SBAR(); if constexpr (VAR != 5) qk_pre<MODE>(kf, K_lds + k2, qr, qrl, kn, kr); ATT_VPRE(vf, vp0 + v1); SBAR(); expA<VAR, C::LSUM>(pB1, l_reg); if constexpr (VAR != 5) qk_run<MODE>(pA0, pA1, cm, kf, K_lds + k2, qr, qrl, kn, kr); SBAR();
          if constexpr (VAR != 4) pv_all_pre<VAR>(o, vp0 + v1, pB0, pB1, vf); } expA<VAR, C::LSUM>(pA0, l_reg);
        SYNCK();
        { const int t = k0; k0 = k2; k2 = k1; k1 = t; }
        { const int t = v0; v0 = v2; v2 = v1; v1 = t; }
    }
    SYNC();
    { QkFrag<MODE> kf[NQ]; SBAR(); if constexpr (VAR != 5) qk_pre<MODE>(kf, K_lds + k1, qr, qrl, kn, kr); SBAR(); expA<VAR, C::LSUM>(pA1, l_reg); if constexpr (VAR != 5) qk_run<MODE>(pB0, pB1, cm, kf, K_lds + k1, qr, qrl, kn, kr); SBAR(); }
    if constexpr (VAR != 4) pv_all<VAR, C::LSUM>(o, vp0 + v0, pA0, pA1); expA<VAR, C::LSUM>(pB0, l_reg);
    expA<VAR, C::LSUM>(pB1, l_reg);
    if constexpr (VAR != 4) pv_all<VAR, C::LSUM>(o, vp0 + v1, pB0, pB1);
    }
    l_reg += __shfl_xor(l_reg, 32);
    static_assert(!C::LSUM, "");
    const float rl = __builtin_amdgcn_rcpf(l_reg);
#define ATT_STORE_ROW(SC) do { bf16_t* Ow = Od + (size_t)(orow0 + (wid & (MODE == 0 ? 3 : 7)) * 32 + r32) * D + 8 * hi; \
        _Pragma("unroll") for (int d0 = 0; d0 < 4; ++d0) \
            _Pragma("unroll") for (int m = 0; m < 2; ++m) { \
                unsigned a0 = cvtpk(o[d0][8 * m + 0] * (SC), o[d0][8 * m + 1] * (SC)), a1 = cvtpk(o[d0][8 * m + 2] * (SC), o[d0][8 * m + 3] * (SC)); \
                unsigned b0 = cvtpk(o[d0][8 * m + 4] * (SC), o[d0][8 * m + 5] * (SC)), b1 = cvtpk(o[d0][8 * m + 6] * (SC), o[d0][8 * m + 7] * (SC)); \
                auto r0 = __builtin_amdgcn_permlane32_swap(a0, b0, false, false); auto r1 = __builtin_amdgcn_permlane32_swap(a1, b1, false, false); \
                u32x4 w = {r0[0], r1[0], r0[1], r1[1]}; *reinterpret_cast<u32x4*>(Ow + d0 * 32 + m * 16) = w; } } while (0)
    if constexpr (MODE == 1) {
        ATT_STORE_ROW(rl);
        __syncthreads();
    } else {
        float* X = (float*)lds;
#pragma unroll
        for (int d0 = 0; d0 < 4; ++d0)
#pragma unroll
            for (int r = 0; r < 16; ++r) o[d0][r] *= rl;
        __syncthreads();
        if (wid >= 4) {
#pragma unroll
            for (int d0 = 0; d0 < 4; ++d0)
#pragma unroll
                for (int r = 0; r < 16; ++r) X[((wid - 4) * 64 + d0 * 16 + r) * 64 + lane] = o[d0][r];
        }
        __syncthreads();
        if (wid < 4) {
            float ss = 0.f;
#pragma unroll
            for (int d0 = 0; d0 < 4; ++d0)
#pragma unroll
                for (int r = 0; r < 16; ++r) { const float a = o[d0][r] - lam * X[(wid * 64 + d0 * 16 + r) * 64 + lane]; o[d0][r] = a; ss += a * a; }
            ss += __shfl_xor(ss, 32);
            const float rs = (1.0f - LAM_INIT0) / sqrtf(ss * (1.0f / 128.0f) + EPS);
            ATT_STORE_ROW(rs);
        }
        __syncthreads();
    }
#undef ATT_STORE_ROW
#undef TROW
#undef DMA16
#undef LOADK
#undef LOADV
#undef SYNC
#undef SYNCK
}
}
struct Args { const float* in[30]; float* out; unsigned char* ws; int ph_lo, ph_hi; };
enum { I_X = 0, I_C, I_CTX, I_CCTX, I_N1G, I_N2G, I_MODW, I_MODB, I_EWIN, I_POOLW, I_POOLS, I_LQ1, I_LK1, I_LQ2, I_LK2, I_EWOUT, I_FG, I_FU, I_FD,
       I_OWIN, I_QNG, I_KVNG, I_WUQ, I_WUKV, I_OWOUT, I_RTW, I_MG, I_MU, I_MD, I_FNG };

__device__ __forceinline__ void tr_load(const float* W, int N, int k0, int n0, const float* ksc, LAS float* scr, int lane) {
    float v[32];
#pragma unroll
    for (int i = 0; i < 32; ++i) v[i] = W[(size_t)(k0 + 2 * i + (lane >> 5)) * N + n0 + (lane & 31)];
    if (ksc) {
#pragma unroll
        for (int i = 0; i < 32; ++i) v[i] *= ksc[k0 + 2 * i + (lane >> 5)]; }
#pragma unroll
    for (int i = 0; i < 32; ++i) scr[(2 * i + (lane >> 5)) * 33 + (lane & 31)] = v[i];
    LDS_WAIT(); asm volatile("" ::: "memory");
}
__device__ __forceinline__ void tr_store(bf16_t* drow0, int ldk, int k0, LAS float* scr, int lane) {
    const int c = lane & 7;
#pragma unroll
    for (int j = 0; j < 4; ++j) { const int n = (lane >> 3) + 8 * j; const LAS float* s = scr + (8 * c) * 33 + n;
        u32x4 o; o.x = pk2(s[0 * 33], s[1 * 33]); o.y = pk2(s[2 * 33], s[3 * 33]); o.z = pk2(s[4 * 33], s[5 * 33]); o.w = pk2(s[6 * 33], s[7 * 33]);
        *(u32x4*)(drow0 + (size_t)n * ldk + k0 + 8 * c) = o; }
    LDS_WAIT(); asm volatile("" ::: "memory");
}
__device__ __forceinline__ void tr_item(const float* W, int N, int it, const float* ksc, bf16_t* dst, int ldk, int rowmode, LAS float* scr, int lane) {
    const int nblk = N / 32, kb = it / nblk, nb = it - kb * nblk, k0 = 64 * kb, n0 = 32 * nb;
    const int drow0 = rowmode == 0 ? n0 : (256 * (n0 >> 7) + (n0 & 127) + (rowmode == 2 ? 128 : 0));
    tr_load(W, N, k0, n0, ksc, scr, lane);
    tr_store(dst + (size_t)drow0 * ldk, ldk, k0, scr, lane);
}
__device__ __forceinline__ void tr_item_fold(const float* W, const float* pw, const float* ps, int it, bf16_t* dst, LAS float* scr, int lane) {
    const int g = it / 32, nb = it - g * 32, k0 = 64 * g, n0 = 32 * nb, n = lane & 31, half = lane >> 5;
    tr_load(W, D, k0, n0, nullptr, scr, lane);
    float acc[32];
#pragma unroll
    for (int i = 0; i < 32; ++i) acc[i] = 0.f;
    for (int e = 0; e < 64; ++e) { const float x = scr[e * 33 + n] * ps[k0 + e];
#pragma unroll
        for (int i = 0; i < 32; ++i) acc[i] += pw[(size_t)(k0 + 2 * i + half) * 64 + e] * x; }
    LDS_WAIT(); asm volatile("" ::: "memory");
#pragma unroll
    for (int i = 0; i < 32; ++i) scr[(2 * i + half) * 33 + n] = acc[i];
    LDS_WAIT(); asm volatile("" ::: "memory");
    tr_store(dst + (size_t)n0 * D, D, k0, scr, lane);
}

__device__ __forceinline__ void norm_mod_row(const float* __restrict__ hrow, const float* __restrict__ g, const float* __restrict__ sh, const float* __restrict__ sc, bf16_t* __restrict__ orow, int lane, f32x4 (&a)[4]) {
    const f32x4* xr = (const f32x4*)hrow + lane; float s = 0.f; f32x4 gv[4], sv[4], cv[4];
#pragma unroll
    for (int j = 0; j < 4; ++j) a[j] = xr[64 * j];
#pragma unroll
    for (int j = 0; j < 4; ++j) { gv[j] = ((const f32x4*)g)[64 * j + lane]; sv[j] = ((const f32x4*)sh)[64 * j + lane]; cv[j] = ((const f32x4*)sc)[64 * j + lane]; }
#pragma unroll
    for (int j = 0; j < 4; ++j) s += (a[j][0] * a[j][0] + a[j][1] * a[j][1]) + (a[j][2] * a[j][2] + a[j][3] * a[j][3]);
    const float r = 1.0f / sqrtf(wave_sum(s) * (1.0f / D) + EPS);
    u32x2* o8 = (u32x2*)orow + lane; u32x2 w[4];
#pragma unroll
    for (int j = 0; j < 4; ++j) { a[j] = (a[j] * r) * gv[j] * (1.0f + cv[j]) + sv[j]; w[j].x = cvtpk(a[j][0], a[j][1]); w[j].y = cvtpk(a[j][2], a[j][3]); }
#pragma unroll
    for (int j = 0; j < 4; ++j) o8[64 * j] = w[j];
}
template <bool BF, int NR> __device__ __forceinline__ void norm_rowsN(const char* __restrict__ h, const f32x4 (&gs)[4], const f32x4 (&sv)[4], bf16_t* __restrict__ o, int lane) {
    constexpr size_t RB = BF ? 2 * D : 4 * D;
    f32x4 a[NR][4]; float ss[NR];
    if constexpr (BF) { u32x2 raw[NR][4];
#pragma unroll
        for (int q = 0; q < NR; ++q)
#pragma unroll
            for (int j = 0; j < 4; ++j) raw[q][j] = ((const u32x2*)(h + q * RB) + lane)[64 * j];
#pragma unroll
        for (int q = 0; q < NR; ++q)
#pragma unroll
            for (int j = 0; j < 4; ++j) a[q][j] = epi::bf4_f(raw[q][j].x, raw[q][j].y); }
    else {
#pragma unroll
        for (int q = 0; q < NR; ++q)
#pragma unroll
            for (int j = 0; j < 4; ++j) a[q][j] = ((const f32x4*)(h + q * RB) + lane)[64 * j]; }
#pragma unroll
    for (int q = 0; q < NR; ++q) { float s = 0.f;
#pragma unroll
        for (int j = 0; j < 4; ++j) s += (a[q][j][0] * a[q][j][0] + a[q][j][1] * a[q][j][1]) + (a[q][j][2] * a[q][j][2] + a[q][j][3] * a[q][j][3]);
        ss[q] = s; }
#pragma unroll
    for (int x = 1; x < 64; x <<= 1)
#pragma unroll
        for (int q = 0; q < NR; ++q) ss[q] += __shfl_xor(ss[q], x);
#pragma unroll
    for (int q = 0; q < NR; ++q) { const float r = 1.0f / sqrtf(ss[q] * (1.0f / D) + EPS); u32x2* p = (u32x2*)(o + (size_t)q * D) + lane;
#pragma unroll
        for (int j = 0; j < 4; ++j) { const f32x4 y = (a[q][j] * r) * gs[j] + sv[j]; u32x2 w; w.x = cvtpk(y[0], y[1]); w.y = cvtpk(y[2], y[3]); p[64 * j] = w; } }
}
template <bool BF> __device__ __forceinline__ void norm_phase(const void* hl, const void* hc, const float* ng, const float* modl, int ch, bf16_t* A, int nrows, int gw, int ngw, int lane) {
    constexpr size_t RB = BF ? 2 * D : 4 * D;
    f32x4 gv[4], gs[4], sv[4];
#pragma unroll
    for (int j = 0; j < 4; ++j) gv[j] = ((const f32x4*)ng)[64 * j + lane];
    for (int r0 = gw * 16; r0 < NLAT; r0 += ngw * 16) {
        const float* mv = modl + (r0 >> 14) * NMOD;
#pragma unroll
        for (int j = 0; j < 4; ++j) { gs[j] = gv[j] * (((const f32x4*)(mv + (ch + 1) * D))[64 * j + lane] + 1.0f); sv[j] = ((const f32x4*)(mv + ch * D))[64 * j + lane]; }
        for (int q = 0; q < 16; q += 4) norm_rowsN<BF, 4>((const char*)hl + (size_t)(r0 + q) * RB, gs, sv, A + (size_t)(r0 + q) * D, lane);
    }
    if (nrows > NLAT && NLAT + gw < nrows) {
        const float* mv = modl + 2 * NMOD;
#pragma unroll
        for (int j = 0; j < 4; ++j) { gs[j] = gv[j] * (((const f32x4*)(mv + (ch + 1) * D))[64 * j + lane] + 1.0f); sv[j] = ((const f32x4*)(mv + ch * D))[64 * j + lane]; }
        for (int r = NLAT + gw; r < nrows; r += ngw) norm_rowsN<BF, 1>((const char*)hc + (size_t)(r - NLAT) * RB, gs, sv, A + (size_t)r * D, lane);
    }
}

__global__ void __launch_bounds__(NTHR, 2) fwd_kernel(Args args) {
    extern __shared__ __attribute__((aligned(16))) unsigned char lds[];
    LAS unsigned char* ldsl = (LAS unsigned char*)lds;
    volatile LAS unsigned* MISC = (volatile LAS unsigned*)(ldsl + MISC_OFF);
    const int wave = __builtin_amdgcn_readfirstlane(threadIdx.x >> 6);
    const int G = gridDim.x, bx = blockIdx.x, gw = bx * NW + wave, ngw = G * NW;
    unsigned* ctl0 = (unsigned*)(args.ws + WS_CTL);
    for (int u = threadIdx.x; u < (LDS_BYTES - MISC_OFF) / 4; u += NTHR) MISC[u] = 0u;
    __syncthreads();
    XcdBarrier bar = xcd_barrier_post(ctl0 + CW_BAR, MISC);
    const int lo = args.ph_lo, hi_ = args.ph_hi;
#define PHASE_PTRS unsigned char* ws = args.ws; asm volatile("" : "+s"(ws)); float* OUT = args.out; asm volatile("" : "+s"(OUT)); unsigned* ctl = (unsigned*)(ws + WS_CTL); float* modv = (float*)(ws + WS_TAB); f32x2* rope = (f32x2*)(ws + WS_TAB + TAB_ROPE); int* midx = (int*)(ws + WS_TAB + TAB_IDX); float* mwgt = (float*)(ws + WS_TAB + TAB_WGT); float* ssq_q = (float*)(ws + CTL_SSQQ); float* ssq_kv = (float*)(ws + CTL_SSQKV); unsigned* kmax2 = (unsigned*)(ws + 65536); unsigned* knmax2 = (unsigned*)(ws + 65536 + 1024); unsigned* krmax2 = (unsigned*)(ws + 65536 + 2048); bf16_t* HC = (bf16_t*)(ws + WS_HC); bf16_t* HS = (bf16_t*)(OUT + (size_t)NLAT * D / 2); (void)HS; bf16_t* Wb = (bf16_t*)(ws + WS_W); bf16_t* Abuf = (bf16_t*)(ws + WS_A); unsigned char* big = ws + WS_BIG; (void)ctl; (void)modv; (void)rope; (void)midx; (void)mwgt; (void)ssq_q; (void)ssq_kv; (void)kmax2; (void)knmax2; (void)krmax2; (void)HC; (void)Wb; (void)Abuf; (void)big; (void)OUT;
#define INP(i) ({ int _i = (i); asm volatile("" : "+s"(_i)); args.in[_i]; })
#ifndef ONLY_PHASE
#define ONLY_PHASE -1
#endif
#ifndef REPEAT_PHASE
#define REPEAT_PHASE -1
#endif
#define IN(k) ((ONLY_PHASE < 0 || ONLY_PHASE == (k)) && lo <= (k) && (k) < hi_)
#ifndef REPN
#define REPN 2
#endif
#define REP(k) for (int rep_ = 0; rep_ < ((REPEAT_PHASE == (k)) ? REPN : 1); ++rep_)
#define SEAM(k) do { if (IN(k) && IN((k) + 1)) xcd_barrier(bar); } while (0)

    constexpr int N_IN0 = 16 * 80, N_OUT0 = 16 * 32, N_G0 = 16 * 88, N_D0 = 44 * 32, N_IN1 = 16 * 26, N_Z1 = 192, N_UQ = 8 * 48, N_UKV = 4 * 64, N_OUT1 = 16 * 32;
    constexpr int NITEMS = N_IN0 + N_OUT0 + 2 * N_G0 + N_D0 + N_IN1 + N_Z1 + N_UQ + N_UKV + N_OUT1;
#define LAYER_WCONV(lo_, hi_i) do { LAS float* scr = (LAS float*)(ldsl + wave * 16384); \
        for (int it = (lo_) + gw; it < (hi_i); it += ngw) { \
            int r = it; \
            if (r < N_IN0) { tr_item(INP(I_EWIN), 2560, r, nullptr, Wb + W_IN0 / 2, D, 0, scr, lane); continue; } r -= N_IN0; \
            if (r < N_OUT0) { if (r < 128) tr_item_fold(INP(I_EWOUT), INP(I_POOLW), INP(I_POOLS), r, Wb + W_OUT0 / 2, scr, lane); \
                              else tr_item(INP(I_EWOUT), D, r, nullptr, Wb + W_OUT0 / 2, D, 0, scr, lane); continue; } r -= N_OUT0; \
            if (r < N_G0) { tr_item(INP(I_FG), FF, r, nullptr, Wb + W_GU0 / 2, D, 1, scr, lane); continue; } r -= N_G0; \
            if (r < N_G0) { tr_item(INP(I_FU), FF, r, nullptr, Wb + W_GU0 / 2, D, 2, scr, lane); continue; } r -= N_G0; \
            if (r < N_D0) { tr_item(INP(I_FD), D, r, nullptr, Wb + W_DN0 / 2, FF, 0, scr, lane); continue; } r -= N_D0; \
            if (r < N_IN1) { tr_item(INP(I_OWIN), 832, r, nullptr, Wb + W_IN1 / 2, D, 0, scr, lane); continue; } r -= N_IN1; \
            if (r < N_Z1) { u32x4* z = (u32x4*)(Wb + W_IN1 / 2 + (size_t)(832 + r) * D); z[lane] = (u32x4){0u, 0u, 0u, 0u}; z[64 + lane] = (u32x4){0u, 0u, 0u, 0u}; continue; } r -= N_Z1; \
            if (r < N_UQ) { tr_item(INP(I_WUQ), 1536, r, INP(I_QNG), Wb + W_UQ / 2, 512, 0, scr, lane); continue; } r -= N_UQ; \
            if (r < N_UKV) { tr_item(INP(I_WUKV), 2048, r, INP(I_KVNG), Wb + W_UKV / 2, 256, 0, scr, lane); continue; } r -= N_UKV; \
            tr_item(INP(I_OWOUT), D, r, nullptr, Wb + W_OUT1 / 2, D, 0, scr, lane); } } while (0)
    asm volatile("; ===PHASE 0");
    REP(0) if (IN(0)) { const int tid = opaque_tid(), lane = tid & 63; (void)tid; (void)lane; PHASE_PTRS
        if (bx < 192) {
            const int i = bx / 96, n = (bx % 96) * 64 + lane; const float* mw = INP(I_MODW) + (size_t)i * D * NMOD + n;
            const float* c0 = INP(I_C), *c1 = INP(I_C) + D, *c2 = INP(I_CCTX);
            LAS float* sil = (LAS float*)ldsl + 2048;
            for (int e = tid; e < 3 * D; e += NTHR) { const int v = e >> 10, k = e & (D - 1); const float x = (v == 0) ? c0[k] : (v == 1) ? c1[k] : c2[k]; sil[e] = x / (1.0f + expf(-x)); }
            __syncthreads();
            float a0 = 0.f, a1 = 0.f, a2 = 0.f;
            for (int kk = 0; kk < 128; kk += 16) { float w[16];
#pragma unroll
                for (int q = 0; q < 16; ++q) w[q] = mw[(size_t)(wave * 128 + kk + q) * NMOD];
#pragma unroll
                for (int q = 0; q < 16; ++q) { const int k = wave * 128 + kk + q; a0 += sil[k] * w[q]; a1 += sil[D + k] * w[q]; a2 += sil[2 * D + k] * w[q]; } }
            LAS float* red = (LAS float*)ldsl;
            red[(wave * 3 + 0) * 64 + lane] = a0; red[(wave * 3 + 1) * 64 + lane] = a1; red[(wave * 3 + 2) * 64 + lane] = a2;
            __syncthreads();
            if (wave < 3) { float s = INP(I_MODB)[i * NMOD + n];
#pragma unroll
                for (int w = 0; w < 8; ++w) s += red[(w * 3 + wave) * 64 + lane];
                modv[(i * 3 + wave) * NMOD + n] = s; }
            __syncthreads();
        } else if (bx == 200) {
            for (int e = tid; e < 4096; e += NTHR) { const int a = e >> 4, i = e & 15; const float inv = exp2f(-(float)i * (13.287712379549449f / 16.0f));
                double rev = (double)((float)a * inv) * 0.15915494309189535; rev -= rint(rev); const float fr = (float)rev;
                rope[e] = (f32x2){__builtin_amdgcn_cosf(fr), __builtin_amdgcn_sinf(fr)}; }
        }
        LAYER_WCONV(0, N_IN0);
    }
    SEAM(0);
    asm volatile("; ===PHASE 1");
    REP(1) if (IN(1)) { const int tid = opaque_tid(), lane = tid & 63; (void)tid; (void)lane; PHASE_PTRS norm_phase<false>(INP(I_X), INP(I_CTX), INP(I_N1G), modv, 0, Abuf, NROW, gw, ngw, lane); }
    SEAM(1);
    asm volatile("; ===PHASE 2");
    REP(2) if (IN(2)) { const int tid = opaque_tid(), lane = tid & 63; (void)tid; (void)lane; PHASE_PTRS
        pg8::Gemm g{Abuf, Wb + W_IN0 / 2, NROW, 2560, D, nullptr, 0}; pg8::StaticOrder S; S.init(NROW, 2560, G, bx);
        epi::EpiIn0 E{(float*)(big + B_P), (bf16_t*)(big + B_Q), (bf16_t*)(big + B_K), (bf16_t*)(big + B_V), rope, kmax2, ldsl + 144 * 1024};
        pg8::gemm_run<epi::EpiIn0, true, true>(ldsl, g, S, E);
    }
    SEAM(2);
    asm volatile("; ===PHASE 3");
    if (IN(3)) { const int tid = opaque_tid(), lane = tid & 63; (void)tid; (void)lane; PHASE_PTRS
        const bool conv_first3 = ((bx >> 3) & 1) == 0;
        if (conv_first3) { LAYER_WCONV(N_IN0, NITEMS); __syncthreads(); }
        const float* P = (const float*)(big + B_P); bf16_t* MIX = (bf16_t*)(big + B_MIX);
        for (int blk = gw; blk < NROW / 16; blk += ngw) {
            const int m0 = blk * 16;
            int sb, t0, L; if (m0 < NLAT) { sb = m0 & ~(SEQ - 1); t0 = m0 & (SEQ - 1); L = SEQ; } else { sb = NLAT + ((m0 - NLAT) & ~(CTX - 1)); t0 = (m0 - NLAT) & (CTX - 1); L = CTX; }
            f32x4 r[32];
#pragma unroll
            for (int j = 0; j < 32; ++j) { const int tt = t0 - 8 + j; const bool ok = (tt >= 0) && (tt < L);
                const f32x4 x = *(const f32x4*)(P + (size_t)(sb + (ok ? tt : t0)) * 256 + lane * 4); r[j] = ok ? x : (f32x4){0.f, 0.f, 0.f, 0.f}; }
            const int g = lane >> 4, half = 1 << g;
            f32x4 w1 = r[7] + r[8], w2 = w1 + (r[6] + r[9]), w4 = w2 + ((r[4] + r[5]) + (r[10] + r[11])), w8 = w4 + (((r[0] + r[1]) + (r[2] + r[3])) + ((r[12] + r[13]) + (r[14] + r[15])));
#pragma unroll
            for (int i = 0; i < 16; ++i) { const int t = t0 + i, tlo = max(t - half, 0), thi = min(t + half, L);
                const f32x4 s = (g == 0) ? w1 : (g == 1) ? w2 : (g == 2) ? w4 : w8;
                const float rc = 1.0f / (float)(thi - tlo);
                epi::st_bf4(MIX + (size_t)(m0 + i) * D + lane * 4, s * rc - r[i + 8]);
                if (i < 15) { w1 += r[i + 9] - r[i + 7]; w2 += r[i + 10] - r[i + 6]; w4 += r[i + 12] - r[i + 4]; w8 += r[i + 16] - r[i]; } }
        }
        float lam;
        { const float d1 = wave_sum(INP(I_LQ1)[lane] * INP(I_LK1)[lane]), d2 = wave_sum(INP(I_LQ2)[lane] * INP(I_LK2)[lane]); lam = expf(d1) - expf(d2) + LAM_INIT0; }
        const bf16_t* Qb = (const bf16_t*)(big + B_Q); const bf16_t* Kb = (const bf16_t*)(big + B_K); const bf16_t* Vb = (const bf16_t*)(big + B_V);
        const int r32 = lane & 31, hi = lane >> 5, map = wave >> 2, w4 = wave & 3;
        constexpr int NU_LAT = NB * 6 * (SEQ / 128), NU = NU_LAT + NB * 6 * (CTX / 128);
        const int vbx = (G == 256) ? ((bx & 7) * 32 + (bx >> 3)) : bx;
        for (int uu = vbx; uu < NU * ((REPEAT_PHASE == 3) ? 2 : 1); uu += G) { const int u = uu >= NU ? uu - NU : uu;
            int b, h, qrow0, lat0, nlt, ctx0, NT;
            if (u < NU_LAT) { const int qb = u & 127, bh = u >> 7; b = bh / 6; h = bh - b * 6; qrow0 = b * SEQ + qb * 128; lat0 = b * SEQ; nlt = SEQ / 64; ctx0 = NLAT + b * CTX; NT = nlt + CTX / 64; }
            else { const int v = u - NU_LAT, qb = v & 1, bh = v >> 1; b = bh / 6; h = bh - b * 6; qrow0 = NLAT + b * CTX + qb * 128; lat0 = 0; nlt = 0; ctx0 = NLAT + b * CTX; NT = CTX / 64; }
            const bf16_t* Qw = Qb + (size_t)(qrow0 + w4 * 32 + r32) * 768 + h * 128 + map * 64 + hi * 8;
            att::attn_unit<0>(Qw, Kb + h * 128, Vb + (size_t)h * 128 * NROW, nullptr, lat0, nlt, ctx0, NT, MIX + 256 + h * 128, qrow0, lam, (const float*)kmax2 + (b * 6 + h) * 4, nullptr, (char*)lds, ldsl);
        }
        if (!conv_first3) { __syncthreads(); LAYER_WCONV(N_IN0, NITEMS); }
#ifdef SHADOW_VAR
        for (int u = bx; u < NU; u += G) {
            int b, h, qrow0, lat0, nlt, ctx0, NT;
            if (u < NU_LAT) { const int qb = u & 127, bh = u >> 7; b = bh / 6; h = bh - b * 6; qrow0 = b * SEQ + qb * 128; lat0 = b * SEQ; nlt = SEQ / 64; ctx0 = NLAT + b * CTX; NT = nlt + CTX / 64; }
            else { const int v = u - NU_LAT, qb = v & 1, bh = v >> 1; b = bh / 6; h = bh - b * 6; qrow0 = NLAT + b * CTX + qb * 128; lat0 = 0; nlt = 0; ctx0 = NLAT + b * CTX; NT = CTX / 64; }
            const bf16_t* Qw = Qb + (size_t)(qrow0 + w4 * 32 + r32) * 768 + h * 128 + map * 64 + hi * 8;
            att::attn_unit<0, SHADOW_VAR>(Qw, Kb + h * 128, Vb + (size_t)h * 128 * NROW, nullptr, lat0, nlt, ctx0, NT, (bf16_t*)(big + B_XS) + 256 + h * 128, qrow0, lam, (const float*)kmax2 + (b * 6 + h) * 4, nullptr, (char*)lds, ldsl);
        }
#endif
    }
    SEAM(3);
    asm volatile("; ===PHASE 4");
    REP(4) if (IN(4)) { const int tid = opaque_tid(), lane = tid & 63; (void)tid; (void)lane; PHASE_PTRS
        pg8::Gemm g{(const bf16_t*)(big + B_MIX), Wb + W_OUT0 / 2, NROW, D, D, nullptr, 0}; pg8::StaticOrder S; S.init(NROW, D, G, bx);
        epi::EpiRes<false> E{INP(I_X), HS, INP(I_CTX), HC, modv + 2 * D};
        pg8::gemm_run<epi::EpiRes<false>, true, true>(ldsl, g, S, E);
#if TAIL_PROBE == 4
        for (int rp_ = 0; rp_ < 4; ++rp_) pg8::gemm_tail<epi::EpiRes<false>>(ldsl, g, S, E);
#endif
    }
    SEAM(4);
    asm volatile("; ===PHASE 5");
    REP(5) if (IN(5)) { const int tid = opaque_tid(), lane = tid & 63; (void)tid; (void)lane; PHASE_PTRS norm_phase<true>(HS, HC, INP(I_N2G), modv, 3, Abuf, NROW, gw, ngw, lane);
#if REPEAT_PHASE == 105
        norm_phase<true>(HS, HC, INP(I_N2G), modv, 3, Abuf, NROW, gw, ngw, lane);
#endif
    }
    SEAM(5);
    asm volatile("; ===PHASE 6");
    REP(6) if (IN(6)) { const int tid = opaque_tid(), lane = tid & 63; (void)tid; (void)lane; PHASE_PTRS
        pg8::Gemm g{Abuf, Wb + W_GU0 / 2, NROW, 2 * FF, D, nullptr, 0}; pg8::StaticOrder S; S.init(NROW, 2 * FF, G, bx);
        epi::EpiGU E{(bf16_t*)(big + B_HID)};
        pg8::gemm_run<epi::EpiGU, true, true>(ldsl, g, S, E);
#if TAIL_PROBE == 6
        for (int rp_ = 0; rp_ < 4; ++rp_) pg8::gemm_tail<epi::EpiGU>(ldsl, g, S, E);
#endif
    }
    SEAM(6);
    asm volatile("; ===PHASE 7");
    REP(7) if (IN(7)) { const int tid = opaque_tid(), lane = tid & 63; (void)tid; (void)lane; PHASE_PTRS
        pg8::Gemm g{(const bf16_t*)(big + B_HID), Wb + W_DN0 / 2, NROW, D, FF, nullptr, 0}; pg8::StaticOrder S; S.init(NROW, D, G, bx);
        epi::EpiRes<true> E{HS, HS, HC, HC, modv + 5 * D};
        pg8::gemm_run<epi::EpiRes<true>, true, true>(ldsl, g, S, E);
    }
    SEAM(7);
    asm volatile("; ===PHASE 8");
    REP(8) if (IN(8)) { const int tid = opaque_tid(), lane = tid & 63; (void)tid; (void)lane; PHASE_PTRS norm_phase<true>(HS, HC, INP(I_N1G) + D, modv + 3 * NMOD, 0, Abuf, NROW, gw, ngw, lane); }
    SEAM(8);
    asm volatile("; ===PHASE 9");
    REP(9) if (IN(9)) { const int tid = opaque_tid(), lane = tid & 63; (void)tid; (void)lane; PHASE_PTRS
        pg8::Gemm g{Abuf, Wb + W_IN1 / 2, NROW, D, D, nullptr, 0}; pg8::StaticOrder S; S.init(NROW, D, G, bx);
        epi::EpiIn1 E{(bf16_t*)(big + B_CQ), (bf16_t*)(big + B_CKV), (bf16_t*)(big + B_KR), ssq_q, ssq_kv, rope, krmax2};
        pg8::gemm_run<epi::EpiIn1, true, true>(ldsl, g, S, E);
    }
    SEAM(9);
    asm volatile("; ===PHASE 10");
    REP(10) if (IN(10)) { const int tid = opaque_tid(), lane = tid & 63; (void)tid; (void)lane; PHASE_PTRS
        { pg8::Gemm g{(const bf16_t*)(big + B_CQ), Wb + W_UQ / 2, NLAT, 1536, 512, nullptr, 0}; pg8::StaticOrder S; S.init(NLAT, 1536, G, bx);
          epi::EpiUQ E{(bf16_t*)(big + B_Q1), ssq_q, rope};
          pg8::gemm_run<epi::EpiUQ, true, true>(ldsl, g, S, E); }
        { pg8::Gemm g{(const bf16_t*)(big + B_CKV), Wb + W_UKV / 2, NROW, 2048, 256, nullptr, 0}; pg8::StaticOrder S; S.init(NROW, 2048, G, bx);
          epi::EpiUKV E{(bf16_t*)(big + B_KV1), ssq_kv, knmax2, (bf16_t*)(big + B_VT1), ldsl + 144 * 1024};
          pg8::gemm_run<epi::EpiUKV, true, true>(ldsl, g, S, E); }
    }
    SEAM(10);
    asm volatile("; ===PHASE 11");
    REP(11) if (IN(11)) { const int tid = opaque_tid(), lane = tid & 63; (void)tid; (void)lane; PHASE_PTRS
        const bf16_t* Q1 = (const bf16_t*)(big + B_Q1); const bf16_t* KV1 = (const bf16_t*)(big + B_KV1); const bf16_t* KR = (const bf16_t*)(big + B_KR);
        const int r32 = lane & 31, hi = lane >> 5;
        constexpr int NU = NB * 8 * (SEQ / 256);
        const int vbx11 = (G == 256) ? ((bx & 7) * 32 + (bx >> 3)) : bx;
        for (int u = vbx11; u < NU; u += G) {
            const int qb = u & 63, bh = u >> 6, b = bh >> 3, h = bh & 7, qrow0 = b * SEQ + qb * 256;
            const bf16_t* Qw = Q1 + (size_t)(qrow0 + wave * 32 + r32) * 1536 + h * 192 + hi * 8;
            att::attn_unit<1>(Qw, KV1 + h * 256, (const bf16_t*)(big + B_VT1) + (size_t)h * 128 * NROW, KR, b * SEQ, SEQ / 64, NLAT + b * CTX, SEQ / 64 + CTX / 64, Abuf + h * 128, qrow0, 0.f, (const float*)knmax2 + (b * 8 + h) * 4, (const float*)krmax2 + b * 2, (char*)lds, ldsl);
        }
    }
    SEAM(11);
#define MOE_WCONV() do { LAS float* scr = (LAS float*)(ldsl + wave * 16384); bf16_t* WM = (bf16_t*)(big + B_WM); \
        constexpr int N_G = 16 * 88, N_D = 44 * 32, PER_E = 2 * N_G + N_D; \
        for (int it = gw; it < NEXP * PER_E; it += ngw) { \
            const int e = it / PER_E; int r = it - e * PER_E; bf16_t* we = WM + (size_t)e * ESTRIDE; \
            if (r < N_G) { tr_item(INP(I_MG) + (size_t)e * D * FF, FF, r, nullptr, we, D, 1, scr, lane); continue; } r -= N_G; \
            if (r < N_G) { tr_item(INP(I_MU) + (size_t)e * D * FF, FF, r, nullptr, we, D, 2, scr, lane); continue; } r -= N_G; \
            tr_item(INP(I_MD) + (size_t)e * FF * D, D, r, nullptr, we + (size_t)2 * FF * D, FF, 0, scr, lane); } } while (0)
    asm volatile("; ===PHASE 12");
    REP(12) if (IN(12)) { const int tid = opaque_tid(), lane = tid & 63; (void)tid; (void)lane; PHASE_PTRS
        pg8::Gemm g{Abuf, Wb + W_OUT1 / 2, NLAT, D, D, nullptr, 0}; pg8::StaticOrder S; S.init(NLAT, D, G, bx);
        epi::EpiRes<true> E{HS, HS, HC, HC, modv + 3 * NMOD + 2 * D};
        const bool conv_first = ((bx >> 3) & 1) == 0;
        if (conv_first) { MOE_WCONV(); __syncthreads(); }
        pg8::gemm_run<epi::EpiRes<true>, true, true>(ldsl, g, S, E);
        if (!conv_first) { __syncthreads(); MOE_WCONV(); }
    }
    SEAM(12);
    asm volatile("; ===PHASE 13");
    if (IN(13)) { const int tid = opaque_tid(), lane = tid & 63; (void)tid; (void)lane; PHASE_PTRS
        volatile LAS int* re = (volatile LAS int*)(ldsl + MISC_OFF + 256);
        volatile LAS float* rw = (volatile LAS float*)(ldsl + MISC_OFF + 256 + 1024);
        {
            f32x4 rwr[4][4][2];
#pragma unroll
            for (int j = 0; j < 4; ++j)
#pragma unroll
                for (int c = 0; c < 4; ++c) { const float* p = INP(I_RTW) + (size_t)(4 * (64 * j + lane) + c) * 8; rwr[j][c][0] = *(const f32x4*)p; rwr[j][c][1] = *(const f32x4*)(p + 4); }
            const float* mv = modv + 3 * NMOD + ((bx * 128) >> 14) * NMOD; const float* ng2 = INP(I_N2G) + D;
            f32x4 gm[4], sv[4];
#pragma unroll
            for (int j = 0; j < 4; ++j) { gm[j] = ((const f32x4*)ng2)[64 * j + lane] * (((const f32x4*)(mv + 4 * D))[64 * j + lane] + 1.0f); sv[j] = ((const f32x4*)(mv + 3 * D))[64 * j + lane]; }
            for (int it = 0; it < 16; it += 2) {
                const int tl = wave * 16 + it, m = bx * 128 + tl;
                const u32x2* x0 = (const u32x2*)(HS + (size_t)m * D) + lane; const u32x2* x1 = x0 + D / 4;
                f32x4 a[2][4]; float ss[2] = {0.f, 0.f}; u32x2 ra[2][4];
#pragma unroll
                for (int j = 0; j < 4; ++j) { ra[0][j] = x0[64 * j]; ra[1][j] = x1[64 * j]; }
#pragma unroll
                for (int j = 0; j < 4; ++j) { a[0][j] = epi::bf4_f(ra[0][j].x, ra[0][j].y); a[1][j] = epi::bf4_f(ra[1][j].x, ra[1][j].y); }
#pragma unroll
                for (int q = 0; q < 2; ++q)
#pragma unroll
                    for (int j = 0; j < 4; ++j) ss[q] += (a[q][j][0] * a[q][j][0] + a[q][j][1] * a[q][j][1]) + (a[q][j][2] * a[q][j][2] + a[q][j][3] * a[q][j][3]);
#pragma unroll
                for (int o = 1; o < 64; o <<= 1) { ss[0] += __shfl_xor(ss[0], o); ss[1] += __shfl_xor(ss[1], o); }
                float k1[2];
#pragma unroll
                for (int q = 0; q < 2; ++q) { const float r = 1.0f / sqrtf(ss[q] * (1.0f / D) + EPS); u32x2* o8 = (u32x2*)(Abuf + (size_t)(m + q) * D) + lane;
                    f32x4 l0 = {0.f, 0.f, 0.f, 0.f}, l1 = {0.f, 0.f, 0.f, 0.f};
#pragma unroll
                    for (int j = 0; j < 4; ++j) { const f32x4 y = (a[q][j] * r) * gm[j] + sv[j]; u32x2 w; w.x = cvtpk(y[0], y[1]); w.y = cvtpk(y[2], y[3]); o8[64 * j] = w;
#pragma unroll
                        for (int c = 0; c < 4; ++c) { l0 += rwr[j][c][0] * y[c]; l1 += rwr[j][c][1] * y[c]; } }
                    const bool h5 = (lane & 32) != 0, h4 = (lane & 16) != 0, h3 = (lane & 8) != 0; float k4[4], k2[2];
#pragma unroll
                    for (int i = 0; i < 4; ++i) { const float mine = h5 ? l1[i] : l0[i], send = h5 ? l0[i] : l1[i]; k4[i] = mine + __shfl_xor(send, 32); }
#pragma unroll
                    for (int i = 0; i < 2; ++i) { const float mine = h4 ? k4[2 + i] : k4[i], send = h4 ? k4[i] : k4[2 + i]; k2[i] = mine + __shfl_xor(send, 16); }
                    { const float mine = h3 ? k2[1] : k2[0], send = h3 ? k2[0] : k2[1]; k1[q] = mine + __shfl_xor(send, 8); }
                    k1[q] += __shfl_xor(k1[q], 4); k1[q] += __shfl_xor(k1[q], 2); k1[q] += __shfl_xor(k1[q], 1); }
#pragma unroll
                for (int q = 0; q < 2; ++q) { float lg[8];
#pragma unroll
                    for (int e = 0; e < 8; ++e) lg[e] = __uint_as_float(__builtin_amdgcn_readlane(__float_as_uint(k1[q]), 32 * (e >> 2) + 16 * ((e >> 1) & 1) + 8 * (e & 1)));
                    int e1 = 0; float m1 = lg[0];
#pragma unroll
                    for (int e = 1; e < 8; ++e) if (lg[e] > m1) { m1 = lg[e]; e1 = e; }
                    int e2 = -1; float m2 = -3.0e38f;
#pragma unroll
                    for (int e = 0; e < 8; ++e) if (e != e1 && lg[e] > m2) { m2 = lg[e]; e2 = e; }
                    const float x2 = expf(m2 - m1), w1 = 1.0f / (1.0f + x2), w2 = x2 / (1.0f + x2);
                    if (lane == 0) { re[tl + q] = e1; re[128 + tl + q] = e2; rw[tl + q] = w1; rw[128 + tl + q] = w2; } }
            }
        }
        __syncthreads();
        if (wave < 2 && G == 256) {
            const int s = wave; const int ea = re[s * 128 + lane], eb = re[s * 128 + 64 + lane]; const float wa = rw[s * 128 + lane], wb = rw[s * 128 + 64 + lane];
            const unsigned long long ltm = (1ull << lane) - 1ull;
#pragma unroll
            for (int e = 0; e < 8; ++e) {
                const unsigned long long ma = __ballot(ea == e), mb = __ballot(eb == e);
                const int ca = __popcll(ma), cb = __popcll(mb);
                int base = 0; if (lane == 0 && ca + cb > 0) base = (int)atomicAdd(ctl + CW_CNT + 64 * (s * 8 + e), (unsigned)(ca + cb));
                base = __builtin_amdgcn_readfirstlane(base);
                if (ea == e) { const int pos = base + __popcll(ma & ltm); midx[(size_t)(s * 8 + e) * NLAT + pos] = bx * 128 + lane; mwgt[(size_t)(s * 8 + e) * NLAT + pos] = wa; }
                if (eb == e) { const int pos = base + ca + __popcll(mb & ltm); midx[(size_t)(s * 8 + e) * NLAT + pos] = bx * 128 + 64 + lane; mwgt[(size_t)(s * 8 + e) * NLAT + pos] = wb; }
            }
        }
    }
    SEAM(13);
#define MOE_PREFIX(s) do { __syncthreads(); if (tid < 8) MISC[32 + tid] = __hip_atomic_load(ctl + CW_CNT + 64 * ((s) * 8 + tid), __ATOMIC_RELAXED, __HIP_MEMORY_SCOPE_AGENT); __syncthreads(); \
        if (tid == 0) { int acc_ = 0; for (int e = 0; e < 8; ++e) { MISC[16 + e] = (unsigned)acc_; acc_ += ((int)MISC[32 + e] + 255) >> 8; } MISC[16 + 8] = (unsigned)acc_; } __syncthreads(); } while (0)
#define MOE_GATHER(s) do { const int np_ = (int)MISC[16 + 8]; bf16_t* XS = (bf16_t*)(big + B_XS); \
        for (int r0_ = gw * 4; r0_ < np_ * 256; r0_ += ngw * 4) { int tok_[4]; \
            _Pragma("unroll") for (int q_ = 0; q_ < 4; ++q_) { const int r_ = r0_ + q_; const int pm_ = r_ >> 8; int e_ = 0; for (int k = 1; k < 8; ++k) e_ += (pm_ >= (int)MISC[16 + k]) ? 1 : 0; \
                const int pos_ = r_ - ((int)MISC[16 + e_] << 8); tok_[q_] = pos_ < (int)MISC[32 + e_] ? midx[(size_t)((s) * 8 + e_) * NLAT + pos_] : 0; } \
            u32x4 d_[4][2]; \
            _Pragma("unroll") for (int q_ = 0; q_ < 4; ++q_) { const u32x4* src_ = (const u32x4*)(Abuf + (size_t)tok_[q_] * D); d_[q_][0] = src_[lane]; d_[q_][1] = src_[64 + lane]; } \
            _Pragma("unroll") for (int q_ = 0; q_ < 4; ++q_) { u32x4* dst_ = (u32x4*)(XS + (size_t)(r0_ + q_) * D); dst_[lane] = d_[q_][0]; dst_[64 + lane] = d_[q_][1]; } } } while (0)
#define MOE_GU(s) do { const int np_ = (int)MISC[16 + 8]; pg8::Gemm g{Abuf, (const bf16_t*)(big + B_WM), np_ * 256, 2 * FF, D, (const volatile LAS int*)(MISC + 16), ESTRIDE, midx + (size_t)(s) * 8 * NLAT, (const volatile LAS int*)(MISC + 32)}; \
        pg8::StaticOrder S; S.init(np_ * 256, 2 * FF, G, bx); epi::EpiGU E{(bf16_t*)(big + B_HIDM)}; pg8::gemm_run<epi::EpiGU, true, true, true>(ldsl, g, S, E); } while (0)
#define MOE_DOWN(s) do { const int np_ = (int)MISC[16 + 8]; pg8::Gemm g{(const bf16_t*)(big + B_HIDM), (const bf16_t*)(big + B_WM) + (size_t)2 * FF * D, np_ * 256, D, FF, (const volatile LAS int*)(MISC + 16), ESTRIDE}; \
        pg8::StaticOrder S; S.init(np_ * 256, D, G, bx); epi::EpiMoeDown E{HS, (s) == 1 ? Abuf : HS, modv + 3 * NMOD + 5 * D, midx + (size_t)(s) * 8 * NLAT, mwgt + (size_t)(s) * 8 * NLAT, (const volatile LAS int*)(MISC + 16), (const volatile LAS int*)(MISC + 32)}; \
        pg8::gemm_run<epi::EpiMoeDown, true, true>(ldsl, g, S, E); } while (0)
    asm volatile("; ===PHASE 15");
    REP(15) if (IN(15)) { const int tid = opaque_tid(), lane = tid & 63; (void)tid; (void)lane; PHASE_PTRS MOE_PREFIX(0); MOE_GU(0); }
    SEAM(15);
    asm volatile("; ===PHASE 16");
    REP(16) if (IN(16)) { const int tid = opaque_tid(), lane = tid & 63; (void)tid; (void)lane; PHASE_PTRS MOE_PREFIX(0); MOE_DOWN(0); }
    SEAM(16);
    asm volatile("; ===PHASE 17");
    REP(17) if (IN(17)) { const int tid = opaque_tid(), lane = tid & 63; (void)tid; (void)lane; PHASE_PTRS MOE_PREFIX(1); MOE_GU(1); }
    SEAM(17);
    asm volatile("; ===PHASE 18");
    REP(18) if (IN(18)) { const int tid = opaque_tid(), lane = tid & 63; (void)tid; (void)lane; PHASE_PTRS MOE_PREFIX(1); MOE_DOWN(1); }
    SEAM(18);
    asm volatile("; ===PHASE 19");
    REP(19) if (IN(19)) { const int tid = opaque_tid(), lane = tid & 63; (void)tid; (void)lane; PHASE_PTRS
        const float* fg = INP(I_FNG); float* out19 = OUT;
        f32x4 fgv[4];
#pragma unroll
        for (int j = 0; j < 4; ++j) fgv[j] = ((const f32x4*)fg)[64 * j + lane];
        for (int m = gw * 2; m < NLAT; m += ngw * 2) {
            f32x4* x0 = (f32x4*)(out19 + (size_t)m * D) + lane; f32x4* x1 = x0 + D / 4; f32x4 a[4], b[4]; float s0 = 0.f, s1 = 0.f;
            const u32x2* y0 = (const u32x2*)(Abuf + (size_t)m * D) + lane; const u32x2* y1 = y0 + D / 4; u32x2 ra[4], rb[4];
#pragma unroll
            for (int j = 0; j < 4; ++j) { ra[j] = y0[64 * j]; rb[j] = y1[64 * j]; }
#pragma unroll
            for (int j = 0; j < 4; ++j) { a[j] = epi::bf4_f(ra[j].x, ra[j].y); b[j] = epi::bf4_f(rb[j].x, rb[j].y); }
#pragma unroll
            for (int j = 0; j < 4; ++j) { s0 += (a[j][0] * a[j][0] + a[j][1] * a[j][1]) + (a[j][2] * a[j][2] + a[j][3] * a[j][3]); s1 += (b[j][0] * b[j][0] + b[j][1] * b[j][1]) + (b[j][2] * b[j][2] + b[j][3] * b[j][3]); }
#pragma unroll
            for (int o = 1; o < 64; o <<= 1) { s0 += __shfl_xor(s0, o); s1 += __shfl_xor(s1, o); }
            const float r0 = 1.0f / sqrtf(s0 * (1.0f / D) + EPS), r1 = 1.0f / sqrtf(s1 * (1.0f / D) + EPS);
#pragma unroll
            for (int j = 0; j < 4; ++j) { x0[64 * j] = a[j] * r0 * fgv[j]; x1[64 * j] = b[j] * r1 * fgv[j]; }
        }
    }
#undef IN
#undef SEAM
}

#ifndef N_LAUNCH_MODE
#define N_LAUNCH_MODE 1
#endif
extern "C" void kernel_launch(void* const* d_in, const int* in_sizes, int n_in, void* d_out, int out_size, void* d_ws, size_t ws_size, hipStream_t stream) {
    static int grid = 0;
    if (grid == 0) {
        if (n_in != 30 || out_size != NLAT * D || ws_size < WS_END) { fprintf(stderr, "kernel_launch: unexpected shapes: n_in %d out %d ws %zu (need %zu)\n", n_in, out_size, ws_size, (size_t)WS_END); grid = -1; return; }
        int dev = 0, cus = 0, per_cu = 0;
        if (hipGetDevice(&dev) != hipSuccess || hipDeviceGetAttribute(&cus, hipDeviceAttributeMultiprocessorCount, dev) != hipSuccess) { grid = -1; return; }
        if (hipFuncSetAttribute((const void*)fwd_kernel, hipFuncAttributeMaxDynamicSharedMemorySize, LDS_BYTES) != hipSuccess) { fprintf(stderr, "kernel_launch: hipFuncSetAttribute failed\n"); grid = -1; return; }
        if (hipOccupancyMaxActiveBlocksPerMultiprocessor(&per_cu, (const void*)fwd_kernel, NTHR, LDS_BYTES) != hipSuccess || per_cu < 1) fprintf(stderr, "kernel_launch: occupancy query reports %d\n", per_cu);
        (void)hipGetLastError();
        grid = cus;
        if (grid != 256) { fprintf(stderr, "kernel_launch: built for 256 CUs, found %d\n", grid); grid = -1; return; }
    }
    if (grid < 0) return;
    if (hipMemsetAsync((char*)d_ws + WS_CTL, 0, CTL_ZERO_BYTES, stream) != hipSuccess) return;
    Args a{};
    for (int i = 0; i < 30; ++i) a.in[i] = (const float*)d_in[i];
    a.out = (float*)d_out; a.ws = (unsigned char*)d_ws;
    constexpr int NPH = 20;
    if (N_LAUNCH_MODE == 1) { a.ph_lo = 0; a.ph_hi = NPH; hipLaunchKernelGGL(fwd_kernel, dim3(grid), dim3(NTHR), LDS_BYTES, stream, a); }
    else { for (int p = 0; p < NPH; ++p) { a.ph_lo = p; a.ph_hi = p + 1; hipLaunchKernelGGL(fwd_kernel, dim3(grid), dim3(NTHR), LDS_BYTES, stream, a); } }
    const hipError_t le = hipPeekAtLastError();
    if (le != hipSuccess) fprintf(stderr, "kernel_launch: launch failed: %s\n", hipGetErrorName(le));
}
```

```cpp
#include <hip/hip_runtime.h>
#include <cstdio>
#include <cstdint>

#define GAS __attribute__((address_space(1)))
#define LAS __attribute__((address_space(3)))
typedef unsigned short bf16_t;
typedef short bf16x8 __attribute__((ext_vector_type(8)));
typedef short s16x4 __attribute__((ext_vector_type(4)));
typedef float f32x4 __attribute__((ext_vector_type(4)));
typedef float f32x2 __attribute__((ext_vector_type(2)));
typedef float f32x16 __attribute__((ext_vector_type(16)));
typedef unsigned u32x4 __attribute__((ext_vector_type(4)));
typedef unsigned u32x2 __attribute__((ext_vector_type(2)));

constexpr int D = 1024, NB = 2, SEQ = 16384, CTX = 256, NLAT = NB * SEQ, NCTX = NB * CTX, NROW = NLAT + NCTX;
constexpr int FF = 2816, NEXP = 8, NMOD = 6 * D;
constexpr int NW = 8, NTHR = 512;
constexpr float EPS = 1e-6f;
constexpr float LOG2E = 1.4426950408889634f;
constexpr float QSC0 = 0.125f * LOG2E;
constexpr float QSC1 = 0.07216878364870322f * LOG2E;
constexpr float LAM_INIT0 = 0.2f;

constexpr size_t MiB = 1u << 20;
constexpr size_t WS_CTL = 0, CTL_ZERO_BYTES = 2 * MiB;
constexpr int CW_BAR = 4096;
constexpr int CW_CNT = 8192;
constexpr size_t CTL_SSQQ = 256 * 1024, CTL_SSQKV = 512 * 1024;
constexpr size_t WS_TAB = 2 * MiB;
constexpr size_t TAB_ROPE = 256 * 1024, TAB_IDX = 1 * MiB, TAB_WGT = 3 * MiB;
constexpr size_t WS_HC = 10 * MiB;
constexpr size_t WS_W = 12 * MiB;
constexpr size_t W_IN0 = 0, W_OUT0 = 5 * MiB, W_GU0 = 7 * MiB, W_DN0 = 18 * MiB, W_IN1 = 24 * MiB, W_UQ = 26 * MiB, W_UKV = 28 * MiB, W_OUT1 = 29 * MiB;
constexpr size_t WS_A = 44 * MiB;
constexpr size_t WS_BIG = 109 * MiB;
constexpr size_t B_P = 0, B_Q = (size_t)NROW * 256 * 4, B_K = B_Q + (size_t)NROW * 768 * 2, B_V = B_K + (size_t)NROW * 768 * 2, B_MIX = B_V + (size_t)NROW * 768 * 2;
constexpr size_t B_HID = 0;
constexpr size_t B_CQ = 0, B_CKV = B_CQ + (size_t)NROW * 512 * 2, B_KR = B_CKV + (size_t)NROW * 256 * 2, B_Q1 = 53 * MiB, B_KV1 = 149 * MiB;
constexpr size_t B_VT1 = 279 * MiB;
static_assert(B_KR + (size_t)NROW * 64 * 2 <= B_Q1 && B_VT1 + (size_t)1024 * NROW * 2 <= 387 * MiB, "L1 map");
constexpr size_t ESTRIDE = (size_t)2 * FF * D + (size_t)D * FF;
constexpr size_t B_WM = 0, B_HIDM = 132 * MiB, B_XS = 319 * MiB, BIG_END = 387 * MiB;
constexpr int MAXPAN = 136;
static_assert(NEXP * ESTRIDE * 2 <= B_HIDM && B_HIDM + (size_t)MAXPAN * 256 * FF * 2 <= B_XS && B_XS + (size_t)MAXPAN * 256 * D * 2 <= BIG_END, "MoE map");
constexpr size_t WS_END = WS_BIG + BIG_END;

constexpr int RING_BYTES = 131072, MISC_OFF = 156 * 1024, LDS_BYTES = MISC_OFF + 4096;

#define LDS_WAIT() asm volatile("s_waitcnt lgkmcnt(0)" ::: "memory")
#define VM_WAIT() asm volatile("s_waitcnt vmcnt(0)" ::: "memory")
__device__ __forceinline__ unsigned f2bf(float f) { unsigned u = __builtin_bit_cast(unsigned, f); return (u + 0x7fffu + ((u >> 16) & 1u)) >> 16; }
__device__ __forceinline__ unsigned pk2(float lo, float hi) { return f2bf(lo) | (f2bf(hi) << 16); }
__device__ __forceinline__ unsigned cvtpk(float lo, float hi) { unsigned r; asm volatile("v_cvt_pk_bf16_f32 %0, %1, %2" : "=v"(r) : "v"(lo), "v"(hi)); return r; }
__device__ __forceinline__ int opaque_tid() { int t = threadIdx.x; asm volatile("" : "+v"(t)); return t; }
__device__ __forceinline__ float wave_sum(float v) {
#pragma unroll
    for (int o = 1; o < 64; o <<= 1) v += __shfl_xor(v, o);
    return v;
}

#define XB_TMO      128
#define XB_XCNT(j)  (256  + 64 * (j))
#define XB_XSUB(j)  (1280 + 64 * (j))
#define XB_XGEN(j)  (2304 + 64 * (j))
#define XB_TOP      3328
#define XB_TOPGEN   3392
#define XCD_BAR_WORDS 3456
#define XB_SPIN_CAP (1u << 18)
__device__ __forceinline__ unsigned xb_ld(unsigned* p)              { return __hip_atomic_load(p, __ATOMIC_RELAXED, __HIP_MEMORY_SCOPE_AGENT); }
__device__ __forceinline__ unsigned xb_add(unsigned* p, unsigned v) { return __hip_atomic_fetch_add(p, v, __ATOMIC_RELAXED, __HIP_MEMORY_SCOPE_AGENT); }
__device__ __forceinline__ unsigned xb_xcc_id() { return (unsigned)__builtin_amdgcn_s_getreg((3 << 11) | 20) & 0xFu; }
#define XB_SPIN(cond, bar) do { unsigned _sp = 0; while (cond) { __builtin_amdgcn_s_sleep(1); \
    if ((++_sp & 255u) == 0u) { if (xb_ld(&(bar)[XB_TMO])) break; if (_sp > XB_SPIN_CAP) { atomicAdd(&(bar)[XB_TMO], 1u); break; } } } } while (0)
struct XcdBarrier { unsigned* bar; unsigned x; volatile LAS unsigned* st; };
__device__ __forceinline__ XcdBarrier xcd_barrier_post(unsigned* bar, volatile LAS unsigned* st) {
    XcdBarrier b; b.bar = bar; b.x = xb_xcc_id(); b.st = st;
    if (threadIdx.x == 0) (void)xb_add(&bar[XB_XCNT(b.x)], 1u);
    return b;
}
__device__ __forceinline__ void xcd_barrier_complete(unsigned* bar, unsigned x, unsigned& nloc, unsigned& nx) {
    const unsigned G = gridDim.x * gridDim.y * gridDim.z;
    unsigned sum, cnt, mine, sp = 0u;
    for (;;) {
        sum = 0u; cnt = 0u; mine = 0u;
#pragma unroll
        for (unsigned j = 0; j < 16; ++j) { const unsigned c = xb_ld(&bar[XB_XCNT(j)]); sum += c; cnt += (c > 0u) ? 1u : 0u; mine = (j == x) ? c : mine; }
        if (sum == G) break;
        __builtin_amdgcn_s_sleep(1);
        if ((++sp & 255u) == 0u) { if (xb_ld(&bar[XB_TMO])) break; if (sp > XB_SPIN_CAP) { atomicAdd(&bar[XB_TMO], 1u); break; } }
    }
    nloc = mine > 0u ? mine : 1u; nx = cnt > 0u ? cnt : 1u;
}
__device__ __forceinline__ void xcd_barrier(const XcdBarrier& b) {
    asm volatile("s_waitcnt vmcnt(0)" ::: "memory");
    __syncthreads();
    if (threadIdx.x == 0) {
        unsigned* bar = b.bar;
        __builtin_amdgcn_s_waitcnt(0);
        unsigned nloc = b.st[0], nx = b.st[1];
        if (nloc == 0u) { xcd_barrier_complete(bar, b.x, nloc, nx); b.st[0] = nloc; b.st[1] = nx; }
        const unsigned old = xb_add(&bar[XB_XSUB(b.x)], 1u);
        const unsigned gen = old / nloc;
        if (old + 1u == (gen + 1u) * nloc) {
            __builtin_amdgcn_fence(__ATOMIC_RELEASE, "agent");
            asm volatile("s_waitcnt vmcnt(0)" ::: "memory");
            const unsigned og = xb_add(&bar[XB_TOP], 1u);
            const unsigned tg = og / nx;
            if (og + 1u == (tg + 1u) * nx) xb_add(&bar[XB_TOPGEN], 1u);
            else XB_SPIN(xb_ld(&bar[XB_TOPGEN]) == tg, bar);
            __builtin_amdgcn_fence(__ATOMIC_ACQUIRE, "agent");
            xb_add(&bar[XB_XGEN(b.x)], 1u);
            asm volatile("s_waitcnt vmcnt(0)" ::: "memory");
        } else {
            XB_SPIN(xb_ld(&bar[XB_XGEN(b.x)]) == gen, bar);
            __builtin_amdgcn_fence(__ATOMIC_ACQUIRE, "agent");
            asm volatile("s_waitcnt vmcnt(0)" ::: "memory");
        }
    }
    __syncthreads();
}

namespace pg8 {
constexpr int BM = 256, BK = 64, HALF = 128, HTB = HALF * BK * 2, STAGE_BYTES = 8 * HTB, NXCD = 8, WGM = 4;
__host__ __device__ __forceinline__ int lds_byte(int r, int c) { const int st = (r >> 4) * 2 + (c >> 5), rr = r & 15, cc = c & 31, ob = rr * 64 + cc * 2; return st * 1024 + (ob ^ (((ob >> 9) & 1) << 5)); }
__host__ __device__ __forceinline__ void stage_rc(int b, int& R, int& C) { const int st = b / 1024, sb = b % 1024, swz = sb ^ (((sb >> 9) & 1) << 5); R = (st >> 1) * 16 + swz / 64; C = (st & 1) * 32 + (swz % 64) / 2; }
__host__ __device__ __forceinline__ int perm32(int rho) { const int n = rho >> 4, i = rho & 15; return 8 * (i >> 2) + 4 * n + (i & 3); }
struct Unit { int pm, pn; };
struct Gemm { const bf16_t* A; const bf16_t* Bt; int M, N, K; const volatile LAS int* pb; size_t estride; const int* gidx; const volatile LAS int* gcnt; };
constexpr int TOKBUF = 152 * 1024;
#ifndef TAIL_MAX
#define TAIL_MAX 64
#endif
struct StaticOrder {
    int nM, nN, nwg, G, c, nmain;
    __host__ __device__ void init(int M, int N, int G_, int c_) { nM = M / BM; nN = N / BM; nwg = nM * nN; G = G_; c = c_; const int rem = nwg % G; nmain = (rem > 0 && rem <= TAIL_MAX) ? nwg - rem : nwg; }
    __host__ __device__ bool next(int i, Unit& u) const {
        const long L = (long)i * G + c; if (L >= nmain) return false;
        map((int)L, u); return true;
    }
    __host__ __device__ void map(int L, Unit& u) const {
        int wgid = L; { const int q = nwg / NXCD, r = nwg % NXCD, xcd = wgid % NXCD, off = wgid / NXCD; wgid = (xcd < r ? xcd * (q + 1) : r * (q + 1) + (xcd - r) * q) + off; }
        const int nig = WGM * nN, gid = wgid / nig, fm = gid * WGM, gsz = (nM - fm) < WGM ? (nM - fm) : WGM;
        u.pm = fm + ((wgid % nig) % gsz); u.pn = (wgid % nig) / gsz;
    }
};
__device__ __forceinline__ const char* b_tile(const Gemm& g, const Unit& u, size_t tstep) {
    const char* p = (const char*)g.Bt + (size_t)u.pn * tstep;
    if (g.pb) { int e = 0;
#pragma unroll
        for (int k = 1; k < 8; ++k) e += (u.pm >= g.pb[k]) ? 1 : 0;
        p += (size_t)e * g.estride * 2; }
    return p;
}

template <class Epi, bool ALIGN_EPI = false, bool SP2 = false, bool GATH = false>
__device__ __forceinline__ void gemm_phase(LAS unsigned char* lds, const Gemm g, const StaticOrder& S, const Epi& E) {
    static_assert(!GATH || SP2, "gathered A rows: SP2 loop only");
    const int tid = opaque_tid(), wid = __builtin_amdgcn_readfirstlane(tid >> 6), lane = tid & 63, wr = wid >> 2, wc = wid & 3, fr = lane & 15, fq = lane >> 4;
    const int K = g.K, nt = K / BK;
    unsigned voffA[2], voffB[2];
#pragma unroll
    for (int i = 0; i < 2; ++i) { int R, C; stage_rc(tid * 16 + i * 8192, R, C); const int Rb = Epi::PERM ? ((R & ~31) + perm32(R & 31)) : R;
        voffA[i] = (unsigned)(R * K + C) * 2u; voffB[i] = (unsigned)(Rb * K + C) * 2u; }
    const size_t kstep = (size_t)(BK * 2);
    const size_t hstep = (size_t)HALF * K * 2;
    const size_t tstep = 2 * hstep;
    const unsigned ldsw = (unsigned)wid * 1024u;
    const int aoff = lds_byte(wr * 64 + fr, fq * 8), boff = lds_byte(wc * 32 + fr, fq * 8);
#define PG8_SA(b, h) (((b) * 2 + (h)) * HTB)
#define PG8_SB(b, h) ((4 + (b) * 2 + (h)) * HTB)
#define PG8_STAGE(bufoff, gbase, voff) do { _Pragma("unroll") for (int _i = 0; _i < 2; ++_i) \
        __builtin_amdgcn_global_load_lds((const unsigned*)((const char*)(gbase) + (voff)[_i]), (LAS unsigned*)(lds + (bufoff) + ldsw + _i * 8192), 16, 0, 0); } while (0)
#define PG8_STAGE_A(bufoff, base, h, vv) do { if constexpr (GATH) PG8_STAGE(bufoff, base, (vv)[h]); else PG8_STAGE(bufoff, (base) + (h) * hstep, voffA); } while (0)
#define PG8_LDA(dst, b, h) do { _Pragma("unroll") for (int m = 0; m < 4; ++m) _Pragma("unroll") for (int k = 0; k < 2; ++k) dst[m][k] = *(const LAS bf16x8*)(lds + PG8_SA(b, h) + aoff + m * 2048 + k * 1024); } while (0)
#define PG8_LDB(dst, b, h) do { _Pragma("unroll") for (int n = 0; n < 2; ++n) _Pragma("unroll") for (int k = 0; k < 2; ++k) dst[n][k] = *(const LAS bf16x8*)(lds + PG8_SB(b, h) + boff + n * 2048 + k * 1024); } while (0)
#define PG8_MMA(ai, bj, At, Bt) do { __builtin_amdgcn_s_setprio(1); _Pragma("unroll") for (int m = 0; m < 4; ++m) _Pragma("unroll") for (int n = 0; n < 2; ++n) _Pragma("unroll") for (int k = 0; k < 2; ++k) \
        acc[ai][bj][m][n] = __builtin_amdgcn_mfma_f32_16x16x32_bf16(Bt[n][k], At[m][k], acc[ai][bj][m][n], 0, 0, 0); __builtin_amdgcn_s_setprio(0); } while (0)
#define PG8_WAIT_V(n) asm volatile("s_waitcnt vmcnt(" #n ")" ::: "memory")
#define PG8_WAIT_L(n) asm volatile("s_waitcnt lgkmcnt(" #n ")" ::: "memory")
#define PG8_BAR __builtin_amdgcn_s_barrier()
#define PG8_SCHED __builtin_amdgcn_sched_barrier(0)
    Unit cur, nxt; int ui = 0;
    if (!S.next(0, cur)) return;
    f32x4 acc[2][2][4][2];
#pragma unroll
    for (int a = 0; a < 2; ++a)
#pragma unroll
        for (int b = 0; b < 2; ++b)
#pragma unroll
            for (int m = 0; m < 4; ++m)
#pragma unroll
                for (int n = 0; n < 2; ++n) acc[a][b][m][n] = (f32x4){0.f, 0.f, 0.f, 0.f};
    bf16x8 At[4][2], B0[2][2], B1[2][2];
    unsigned cvA[2][2] = {{0u, 0u}, {0u, 0u}}, xvA[2][2] = {{0u, 0u}, {0u, 0u}};
    if constexpr (GATH) {
        int e = 0;
#pragma unroll
        for (int k = 1; k < 8; ++k) e += (cur.pm >= g.pb[k]) ? 1 : 0;
        const int lp = cur.pm - g.pb[e], n_e = g.gcnt[e];
#pragma unroll
        for (int i = 0; i < 2; ++i) { int R, C; stage_rc(tid * 16 + i * 8192, R, C);
#pragma unroll
            for (int h = 0; h < 2; ++h) { const int pos = lp * 256 + h * 128 + R; const int tok = pos < n_e ? g.gidx[(size_t)e * NLAT + pos] : 0; cvA[h][i] = (unsigned)(tok * K + C) * 2u; } }
    }
    const char* cA = GATH ? (const char*)g.A : (const char*)g.A + (size_t)cur.pm * tstep; const char* cB = b_tile(g, cur, tstep);
    if constexpr (SP2) {
        PG8_STAGE(PG8_SB(0, 0), cB, voffB); PG8_STAGE(PG8_SB(0, 1), cB + hstep, voffB); PG8_STAGE_A(PG8_SA(0, 0), cA, 0, cvA); PG8_STAGE_A(PG8_SA(0, 1), cA, 1, cvA);
        if (wr == 1) PG8_BAR;
        PG8_WAIT_V(2); PG8_BAR;
        PG8_STAGE(PG8_SB(1, 0), cB + kstep, voffB); PG8_STAGE_A(PG8_SA(1, 0), cA + kstep, 0, cvA); PG8_STAGE(PG8_SB(1, 1), cB + hstep + kstep, voffB);
        PG8_WAIT_V(6); PG8_BAR;
    } else {
        PG8_STAGE(PG8_SB(0, 0), cB, voffB); PG8_STAGE(PG8_SA(0, 0), cA, voffA); PG8_STAGE(PG8_SB(0, 1), cB + hstep, voffB); PG8_STAGE(PG8_SA(0, 1), cA + hstep, voffA);
        if (wr == 1) PG8_BAR;
        PG8_WAIT_V(4); PG8_BAR;
        PG8_STAGE(PG8_SB(1, 0), cB + kstep, voffB); PG8_STAGE(PG8_SA(1, 0), cA + kstep, voffA); PG8_STAGE(PG8_SB(1, 1), cB + hstep + kstep, voffB);
        PG8_WAIT_V(6); PG8_BAR;
    }
    for (;;) {
        const bool has_next = S.next(ui + 1, nxt);
        const char* nA = (has_next && !GATH) ? (const char*)g.A + (size_t)nxt.pm * tstep : cA; const char* nB = has_next ? b_tile(g, nxt, tstep) : cB;
        int ne = 0, nlp = 0, nn = 0;
        if constexpr (GATH) { if (has_next) {
#pragma unroll
            for (int k = 1; k < 8; ++k) ne += (nxt.pm >= g.pb[k]) ? 1 : 0;
            nlp = nxt.pm - g.pb[ne]; nn = g.gcnt[ne];
            if (wid == 0) __builtin_amdgcn_global_load_lds((const unsigned*)(g.gidx + (size_t)ne * NLAT + nlp * 256 + lane * 4), (LAS unsigned*)(lds + TOKBUF + ((ui + 1) & 1) * 1024), 16, 0, 0); } }
        for (int t = 0; t < nt; t += 2) {
            const bool last = (t == nt - 2);
            const char* a1 = cA + (size_t)(t + 1) * kstep;
            const char* a2 = last ? nA : cA + (size_t)(t + 2) * kstep; const char* b2 = last ? nB : cB + (size_t)(t + 2) * kstep;
            const char* a3 = a2 + kstep; const char* b3 = b2 + kstep;
            if constexpr (GATH) {
                if (last && has_next) {
                    int t2 = tid; asm volatile("" : "+v"(t2));
#pragma unroll
                    for (int i = 0; i < 2; ++i) { int R, C; stage_rc(t2 * 16 + i * 8192, R, C);
#pragma unroll
                        for (int h = 0; h < 2; ++h) { const int r = h * 128 + R; const int tok = (nlp * 256 + r < nn) ? *(const LAS int*)(lds + TOKBUF + ((ui + 1) & 1) * 1024 + r * 4) : 0; xvA[h][i] = (unsigned)(tok * K + C) * 2u; } }
                } else {
#pragma unroll
                    for (int i = 0; i < 2; ++i) { xvA[0][i] = cvA[0][i]; xvA[1][i] = cvA[1][i]; } }
            }
            if constexpr (SP2) {
            PG8_LDB(B0, 0, 0); PG8_LDB(B1, 0, 1); PG8_SCHED; PG8_LDA(At, 0, 0); PG8_STAGE_A(PG8_SA(1, 1), a1, 1, cvA);
            PG8_WAIT_V(8); PG8_WAIT_L(0); PG8_BAR; PG8_MMA(0, 0, At, B0); PG8_MMA(0, 1, At, B1); PG8_BAR; PG8_SCHED;
            PG8_LDA(At, 0, 1); PG8_STAGE(PG8_SB(0, 0), b2, voffB); PG8_STAGE(PG8_SB(0, 1), b2 + hstep, voffB); PG8_STAGE_A(PG8_SA(0, 0), a2, 0, xvA);
            PG8_WAIT_V(8); PG8_WAIT_L(0); PG8_BAR; PG8_MMA(1, 0, At, B0); PG8_MMA(1, 1, At, B1); PG8_BAR; PG8_SCHED;
            PG8_LDB(B0, 1, 0); PG8_LDB(B1, 1, 1); PG8_SCHED; PG8_LDA(At, 1, 0); PG8_STAGE_A(PG8_SA(0, 1), a2, 1, xvA);
            PG8_WAIT_V(8); PG8_WAIT_L(0); PG8_BAR; PG8_MMA(0, 0, At, B0); PG8_MMA(0, 1, At, B1); PG8_BAR; PG8_SCHED;
            PG8_LDA(At, 1, 1); PG8_STAGE(PG8_SB(1, 0), b3, voffB); PG8_STAGE(PG8_SB(1, 1), b3 + hstep, voffB); PG8_STAGE_A(PG8_SA(1, 0), a3, 0, xvA);
            PG8_WAIT_V(8); PG8_WAIT_L(0); PG8_BAR; PG8_MMA(1, 0, At, B0); PG8_MMA(1, 1, At, B1); PG8_BAR; PG8_SCHED;
            } else {
            PG8_LDB(B0, 0, 0); PG8_SCHED; PG8_LDA(At, 0, 0); PG8_STAGE(PG8_SA(1, 1), a1 + hstep, voffA);
            PG8_WAIT_L(8); PG8_BAR; PG8_WAIT_L(0); PG8_MMA(0, 0, At, B0); PG8_BAR; PG8_SCHED;
            PG8_LDB(B1, 0, 1); PG8_STAGE(PG8_SB(0, 0), b2, voffB);
            PG8_BAR; PG8_WAIT_L(0); PG8_MMA(0, 1, At, B1); PG8_BAR;
            PG8_LDA(At, 0, 1); PG8_STAGE(PG8_SA(0, 0), a2, voffA);
            PG8_BAR; PG8_WAIT_L(0); PG8_MMA(1, 0, At, B0); PG8_BAR; PG8_SCHED;
            PG8_STAGE(PG8_SB(0, 1), b2 + hstep, voffB);
            PG8_WAIT_V(6); PG8_BAR; PG8_MMA(1, 1, At, B1); PG8_BAR;
            PG8_LDB(B0, 1, 0); PG8_SCHED; PG8_LDA(At, 1, 0); PG8_STAGE(PG8_SA(0, 1), a2 + hstep, voffA);
            PG8_WAIT_L(8); PG8_BAR; PG8_WAIT_L(0); PG8_MMA(0, 0, At, B0); PG8_BAR; PG8_SCHED;
            PG8_LDB(B1, 1, 1); PG8_STAGE(PG8_SB(1, 0), b3, voffB);
            PG8_BAR; PG8_WAIT_L(0); PG8_MMA(0, 1, At, B1); PG8_BAR;
            PG8_LDA(At, 1, 1); PG8_STAGE(PG8_SA(1, 0), a3, voffA);
            PG8_BAR; PG8_WAIT_L(0); PG8_MMA(1, 0, At, B0); PG8_BAR; PG8_SCHED;
            PG8_STAGE(PG8_SB(1, 1), b3 + hstep, voffB);
            PG8_WAIT_V(6); PG8_BAR; PG8_MMA(1, 1, At, B1); PG8_BAR;
            }
        }
        if constexpr (ALIGN_EPI) { if (wr == 0) PG8_BAR; }
        E(acc, cur, wr, wc, fr, fq);
        if (!has_next) break;
#pragma unroll
        for (int a = 0; a < 2; ++a)
#pragma unroll
            for (int b = 0; b < 2; ++b)
#pragma unroll
                for (int m = 0; m < 4; ++m)
#pragma unroll
                    for (int n = 0; n < 2; ++n) acc[a][b][m][n] = (f32x4){0.f, 0.f, 0.f, 0.f};
        cur = nxt; cA = nA; cB = nB; ++ui;
        if constexpr (GATH) {
#pragma unroll
            for (int i = 0; i < 2; ++i) { cvA[0][i] = xvA[0][i]; cvA[1][i] = xvA[1][i]; } }
        if constexpr (ALIGN_EPI) { if (wr == 1) PG8_BAR; }
    }
    PG8_WAIT_V(0);
    if constexpr (!ALIGN_EPI) { if (wr == 0) PG8_BAR; }
    PG8_BAR;
#undef PG8_SA
#undef PG8_SB
#undef PG8_STAGE
#undef PG8_STAGE_A
#undef PG8_LDA
#undef PG8_LDB
#undef PG8_MMA
#undef PG8_WAIT_V
#undef PG8_WAIT_L
#undef PG8_BAR
#undef PG8_SCHED
}
template <class Epi, bool GATH = false>
__device__ __forceinline__ void gemm_tail(LAS unsigned char* lds, const Gemm g, const StaticOrder& S, const Epi& E) {
    const int ntail = S.nwg - S.nmain; if (ntail <= 0) return;
    const int tid = opaque_tid(), wid = __builtin_amdgcn_readfirstlane(tid >> 6), lane = tid & 63, wr = wid >> 2, wm = wid & 3, fr = lane & 15, fq = lane >> 4;
    const int K = g.K, nt = K / BK;
    unsigned voffA[2];
#pragma unroll
    for (int i = 0; i < 2; ++i) { int R, C; stage_rc(tid * 16 + i * 8192, R, C); voffA[i] = (unsigned)(R * K + C) * 2u; }
    const size_t kstep = (size_t)(BK * 2), hstep = (size_t)HALF * K * 2, tstep = 2 * hstep;
    const unsigned ldsw = (unsigned)wid * 1024u;
    const int aoff = lds_byte(wr * 64 + wm * 16 + fr, fq * 8), binner = lds_byte(fr, fq * 8);
    constexpr int SLOT = HTB + 8192, NS = 6, PF = NS - 1;
#define PT_DMA(src, dst) __builtin_amdgcn_global_load_lds((const unsigned*)(src), (LAS unsigned*)(dst), 16, 0, 0)
#define PT_STAGE(so, kt) do { LAS unsigned char* _l = lds + (so); const char* _a = cA + (size_t)(kt) * kstep; \
        PT_DMA(_a + voffA[0], _l + ldsw); PT_DMA(_a + voffA[1], _l + ldsw + 8192); PT_DMA(cBw + (size_t)(kt) * kstep, _l + HTB + ldsw); } while (0)
    const int nq = (ntail + 7) >> 3;
    for (int t = S.c; t < nq * 64; t += S.G) {
        const int q = (t & 7) + 8 * (t >> 6), sl = (t >> 3) & 7; if (q >= ntail) continue;
        Unit u; S.map(S.nmain + q, u); const int sai = sl >> 2, wcq = sl & 3;
        const char* cA = GATH ? (const char*)g.A : (const char*)g.A + (size_t)u.pm * tstep + (size_t)sai * hstep;
        if constexpr (GATH) {
            int e = 0;
#pragma unroll
            for (int k = 1; k < 8; ++k) e += (u.pm >= g.pb[k]) ? 1 : 0;
            const int lp = u.pm - g.pb[e], n_e = g.gcnt[e];
#pragma unroll
            for (int i = 0; i < 2; ++i) { int R, C; stage_rc(tid * 16 + i * 8192, R, C); const int pos = lp * 256 + sai * 128 + R; const int tok = pos < n_e ? g.gidx[(size_t)e * NLAT + pos] : 0; voffA[i] = (unsigned)(tok * K + C) * 2u; }
        }
        const char* cBw;
        { int R, C; stage_rc((4 * wcq + (wid & 3)) * 1024 + lane * 16, R, C); const int Rb = Epi::PERM ? ((R & ~31) + perm32(R & 31)) : R;
          cBw = b_tile(g, u, tstep) + (size_t)(wid >> 2) * hstep + (size_t)(Rb * K + C) * 2; }
        f32x4 acc[2][2][4][2];
        acc[0][0][0][0] = (f32x4){0.f, 0.f, 0.f, 0.f}; acc[0][0][0][1] = (f32x4){0.f, 0.f, 0.f, 0.f}; acc[0][1][0][0] = (f32x4){0.f, 0.f, 0.f, 0.f}; acc[0][1][0][1] = (f32x4){0.f, 0.f, 0.f, 0.f};
        for (int i = 0; i < PF && i < nt; ++i) PT_STAGE(i * SLOT, i);
        int so = 0, so2 = PF * SLOT;
        for (int kt = 0; kt < nt; ++kt) {
            const int ahead = nt - 1 - kt;
            if (ahead >= 4) asm volatile("s_waitcnt vmcnt(12)" ::: "memory"); else if (ahead == 3) asm volatile("s_waitcnt vmcnt(9)" ::: "memory");
            else if (ahead == 2) asm volatile("s_waitcnt vmcnt(6)" ::: "memory"); else if (ahead == 1) asm volatile("s_waitcnt vmcnt(3)" ::: "memory"); else asm volatile("s_waitcnt vmcnt(0)" ::: "memory");
            __builtin_amdgcn_s_barrier();
            if (kt + PF < nt) PT_STAGE(so2, kt + PF);
            bf16x8 At[2], B0[2][2], B1[2][2];
#pragma unroll
            for (int k = 0; k < 2; ++k) { At[k] = *(const LAS bf16x8*)(lds + so + aoff + k * 1024);
#pragma unroll
                for (int n = 0; n < 2; ++n) { B0[n][k] = *(const LAS bf16x8*)(lds + so + HTB + (2 * n + k) * 1024 + binner); B1[n][k] = *(const LAS bf16x8*)(lds + so + HTB + 4096 + (2 * n + k) * 1024 + binner); } }
#pragma unroll
            for (int k = 0; k < 2; ++k)
#pragma unroll
                for (int n = 0; n < 2; ++n) { acc[0][0][0][n] = __builtin_amdgcn_mfma_f32_16x16x32_bf16(B0[n][k], At[k], acc[0][0][0][n], 0, 0, 0);
                    acc[0][1][0][n] = __builtin_amdgcn_mfma_f32_16x16x32_bf16(B1[n][k], At[k], acc[0][1][0][n], 0, 0, 0); }
            so = (so == (NS - 1) * SLOT) ? 0 : so + SLOT; so2 = (so2 == (NS - 1) * SLOT) ? 0 : so2 + SLOT;
        }
        __builtin_amdgcn_s_barrier();
        E.template run<true>(acc, u, wr, wcq, fr, fq, sai, wm);
    }
#undef PT_DMA
#undef PT_STAGE
}
template <class Epi, bool ALIGN_EPI = false, bool SP2 = false, bool GATH = false>
__device__ __forceinline__ void gemm_run(LAS unsigned char* lds, const Gemm g, const StaticOrder& S, const Epi& E) { gemm_phase<Epi, ALIGN_EPI, SP2, GATH>(lds, g, S, E); gemm_tail<Epi, GATH>(lds, g, S, E); }
}
namespace epi {
using pg8::Unit;
typedef const f32x4 (&AccRef)[2][2][4][2];
__device__ __forceinline__ int vrow(int r) { return r < NLAT ? (r >> 14) : 2; }
__device__ __forceinline__ f32x4 bf4_f(unsigned lo, unsigned hi) { f32x4 r; r[0] = __uint_as_float(lo << 16); r[1] = __uint_as_float(lo & 0xffff0000u); r[2] = __uint_as_float(hi << 16); r[3] = __uint_as_float(hi & 0xffff0000u); return r; }
__device__ __forceinline__ void st_bf4(bf16_t* p, f32x4 v) { u32x2 w; w.x = cvtpk(v[0], v[1]); w.y = cvtpk(v[2], v[3]); *(u32x2*)p = w; }
__device__ __forceinline__ void rope4(f32x4& u1, f32x4& u2, const f32x2* rope, int ang, int i0) {
    const f32x4 cs0 = *(const f32x4*)(rope + ang * 16 + i0), cs1 = *(const f32x4*)(rope + ang * 16 + i0 + 2);
    const f32x4 c = {cs0[0], cs0[2], cs1[0], cs1[2]}, s = {cs0[1], cs0[3], cs1[1], cs1[3]};
    const f32x4 a = u1 * c - u2 * s, b = u2 * c + u1 * s; u1 = a; u2 = b;
}

__device__ __forceinline__ void vt_block(LAS unsigned char* scr, bf16_t* vt, const f32x4& ua, const f32x4& ub, int ca, int cb, int lane) {
    asm volatile("" : "+v"(lane));
    const bool odd = (lane & 1) != 0; const int fr = lane & 15, c0 = odd ? cb : ca;
    const f32x4 keep = odd ? ub : ua, send = odd ? ua : ub; f32x4 recv;
#pragma unroll
    for (int j = 0; j < 4; ++j) recv[j] = __shfl_xor(send[j], 1);
    const int fp = (fr & 2) | ((fr & 4) << 1) | ((fr & 8) >> 1);
#pragma unroll
    for (int j = 0; j < 4; ++j) *(LAS unsigned*)(scr + (c0 + j) * 32 + fp * 2) = odd ? cvtpk(recv[j], keep[j]) : cvtpk(keep[j], recv[j]);
    asm volatile("" ::: "memory");
    const u32x4 q = *(const LAS u32x4*)(scr + (lane >> 1) * 32 + (lane & 1) * 16);
    asm volatile("" ::: "memory");
    *(u32x4*)(vt + (size_t)(lane >> 1) * NROW + (lane & 1) * 8) = q;
}

struct EpiIn0 {
    static constexpr bool PERM = false;
    float* P; bf16_t* Q; bf16_t* K; bf16_t* V; const f32x2* rope; unsigned* kmax2; LAS unsigned char* scr;
    __device__ __forceinline__ void operator()(AccRef acc, const Unit& u, int wr, int wc, int fr, int fq) const { run<false>(acc, u, wr, wc, fr, fq, 0, 0); }
    template <bool SL> __device__ __forceinline__ void run(AccRef acc, const Unit& u, int wr, int wc, int fr, int fq, int sai, int sm) const {
        const int row0 = u.pm * 256 + wr * 64 + fr;
        if (u.pn == 0) {
#pragma unroll
            for (int ai = 0; ai < (SL ? 1 : 2); ++ai)
#pragma unroll
                for (int m = 0; m < (SL ? 1 : 4); ++m) { float* rowp = P + (size_t)(row0 + (SL ? sai : ai) * 128 + (SL ? sm : m) * 16) * 256 + wc * 32 + 4 * fq;
#pragma unroll
                    for (int bj = 0; bj < 2; ++bj)
#pragma unroll
                        for (int n = 0; n < 2; ++n) *(f32x4*)(rowp + bj * 128 + n * 16) = acc[ai][bj][m][n]; }
            return;
        }
        const int sec = (u.pn - 1) / 3, ct = (u.pn - 1) - sec * 3;
        if (sec == 2) {
            LAS unsigned char* ws_ = scr + (SL ? wr * 4 + sm : wr * 4 + wc) * 1024; const int lane = fq * 16 + fr;
#pragma unroll
            for (int ai = 0; ai < (SL ? 1 : 2); ++ai)
#pragma unroll
                for (int m = 0; m < (SL ? 1 : 4); ++m) { const int rb = row0 - fr + (SL ? sai : ai) * 128 + (SL ? sm : m) * 16;
#pragma unroll
                    for (int bj = 0; bj < 2; ++bj) vt_block(ws_, V + (size_t)((2 * ct + bj) * 128 + wc * 32) * NROW + rb, acc[ai][bj][m][0], acc[ai][bj][m][1], 4 * fq, 16 + 4 * fq, lane); }
            return;
        }
        bf16_t* base = Q + (size_t)sec * ((size_t)NROW * 768) + ct * 256 + wc * 32 + 8 * fq;
        const float sc = (sec == 0) ? QSC0 : 1.0f;
        const bool dorope = (sec < 2) && (u.pm < NLAT / 256);
        float kmx[2] = {0.f, 0.f};
#pragma unroll
        for (int ai = 0; ai < (SL ? 1 : 2); ++ai)
#pragma unroll
            for (int m = 0; m < (SL ? 1 : 4); ++m) { const int r = row0 + (SL ? sai : ai) * 128 + (SL ? sm : m) * 16; bf16_t* rowp = base + (size_t)r * 768;
                const int t = r & (SEQ - 1), ang = dorope ? ((wc & 1) ? (t & 63) : (t >> 6)) : 0;
#pragma unroll
                for (int bj = 0; bj < 2; ++bj) { f32x4 u1 = acc[ai][bj][m][0], u2 = acc[ai][bj][m][1];
                    rope4(u1, u2, rope, ang, 4 * fq);
                    if (sec == 1) { float s = ((u1[0] * u1[0] + u1[1] * u1[1]) + (u1[2] * u1[2] + u1[3] * u1[3])) + ((u2[0] * u2[0] + u2[1] * u2[1]) + (u2[2] * u2[2] + u2[3] * u2[3]));
                        s += __shfl_xor(s, 16); s += __shfl_xor(s, 32); kmx[bj] = fmaxf(kmx[bj], s); }
                    { const f32x4 y1 = u1 * sc, y2 = u2 * sc; u32x4 w; w.x = cvtpk(y1[0], y1[1]); w.y = cvtpk(y1[2], y1[3]); w.z = cvtpk(y2[0], y2[1]); w.w = cvtpk(y2[2], y2[3]); *(u32x4*)(rowp + bj * 128) = w; } } if (m == 3) asm volatile("" ::: "memory"); }
        if (sec == 1) { const int b = u.pm < NLAT / 256 ? (u.pm >> 6) : (u.pm - NLAT / 256);
#pragma unroll
            for (int bj = 0; bj < 2; ++bj) { float s = kmx[bj];
#pragma unroll
                for (int o = 1; o < 16; o <<= 1) s = fmaxf(s, __shfl_xor(s, o));
                if (fr == 0 && fq == 0) atomicMax(kmax2 + (((b * 6 + 2 * ct + bj) * 2 + (wc >> 1)) * 2 + (wc & 1)), __float_as_uint(s)); } }
    }
};
template <bool BIN>
struct EpiRes {
    static constexpr bool PERM = true;
    const void* baseL; bf16_t* outL; const void* baseC; bf16_t* outC; const float* gate;
    __device__ __forceinline__ void operator()(AccRef acc, const Unit& u, int wr, int wc, int fr, int fq) const { run<false>(acc, u, wr, wc, fr, fq, 0, 0); }
    template <bool SL> __device__ __forceinline__ void run(AccRef acc, const Unit& u, int wr, int wc, int fr, int fq, int sai, int sm) const {
        const bool lat = u.pm < NLAT / 256;
        const int rbase = lat ? 0 : NLAT;
        const GAS char* bp = (const GAS char*)(lat ? baseL : baseC); GAS bf16_t* op = (GAS bf16_t*)(lat ? outL : outC);
        const int v = lat ? (u.pm >> 6) : 2;
        const int col0 = u.pn * 256 + wc * 32 + 8 * fq, row0 = u.pm * 256 - rbase + wr * 64 + fr;
        constexpr int NA = SL ? 1 : 2, NM = SL ? 1 : 4;
        f32x4 gv[2][2];
#pragma unroll
        for (int bj = 0; bj < 2; ++bj)
#pragma unroll
            for (int n = 0; n < 2; ++n) gv[bj][n] = *(const GAS f32x4*)((const GAS float*)gate + v * NMOD + col0 + bj * 128 + 4 * n);
        if constexpr (BIN) {
#pragma unroll
            for (int ai = 0; ai < NA; ++ai) { u32x4 w[NM][2];
#pragma unroll
                for (int m = 0; m < NM; ++m) { const size_t off = (size_t)(row0 + (SL ? sai : ai) * 128 + (SL ? sm : m) * 16) * D + col0;
#pragma unroll
                    for (int bj = 0; bj < 2; ++bj) w[m][bj] = *(const GAS u32x4*)(bp + (off + bj * 128) * 2); }
#pragma unroll
                for (int m = 0; m < NM; ++m) { const size_t off = (size_t)(row0 + (SL ? sai : ai) * 128 + (SL ? sm : m) * 16) * D + col0;
#pragma unroll
                    for (int bj = 0; bj < 2; ++bj) { const u32x4 x = w[m][bj];
                        const f32x4 r0 = bf4_f(x.x, x.y) + gv[bj][0] * acc[ai][bj][m][0], r1 = bf4_f(x.z, x.w) + gv[bj][1] * acc[ai][bj][m][1];
                        u32x4 o; o.x = cvtpk(r0[0], r0[1]); o.y = cvtpk(r0[2], r0[3]); o.z = cvtpk(r1[0], r1[1]); o.w = cvtpk(r1[2], r1[3]);
                        *(GAS u32x4*)(op + off + bj * 128) = o; } }
                asm volatile("" ::: "memory"); }
        } else {
#pragma unroll
            for (int ai = 0; ai < NA; ++ai) { f32x4 b[NM][2][2];
#pragma unroll
                for (int m = 0; m < NM; ++m) { const size_t off = (size_t)(row0 + (SL ? sai : ai) * 128 + (SL ? sm : m) * 16) * D + col0;
#pragma unroll
                    for (int bj = 0; bj < 2; ++bj) { b[m][bj][0] = *(const GAS f32x4*)(bp + (off + bj * 128) * 4); b[m][bj][1] = *(const GAS f32x4*)(bp + (off + bj * 128 + 4) * 4); } }
#pragma unroll
                for (int m = 0; m < NM; ++m) { const size_t off = (size_t)(row0 + (SL ? sai : ai) * 128 + (SL ? sm : m) * 16) * D + col0;
#pragma unroll
                    for (int bj = 0; bj < 2; ++bj) { const f32x4 r0 = b[m][bj][0] + gv[bj][0] * acc[ai][bj][m][0], r1 = b[m][bj][1] + gv[bj][1] * acc[ai][bj][m][1];
                        u32x4 o; o.x = cvtpk(r0[0], r0[1]); o.y = cvtpk(r0[2], r0[3]); o.z = cvtpk(r1[0], r1[1]); o.w = cvtpk(r1[2], r1[3]);
                        *(GAS u32x4*)(op + off + bj * 128) = o; } }
                asm volatile("" ::: "memory"); }
        }
    }
};
__device__ __forceinline__ float silu_f(float x) { return x * __builtin_amdgcn_rcpf(1.0f + __builtin_amdgcn_exp2f(-x * LOG2E)); }
struct EpiGU {
    static constexpr bool PERM = true;
    bf16_t* H;
    __device__ __forceinline__ void operator()(AccRef acc, const Unit& u, int wr, int wc, int fr, int fq) const { run<false>(acc, u, wr, wc, fr, fq, 0, 0); }
    template <bool SL> __device__ __forceinline__ void run(AccRef acc, const Unit& u, int wr, int wc, int fr, int fq, int sai, int sm) const {
        const int row0 = u.pm * 256 + wr * 64 + fr, col0 = u.pn * 128 + wc * 32 + 8 * fq;
#pragma unroll
        for (int ai = 0; ai < (SL ? 1 : 2); ++ai)
#pragma unroll
            for (int m = 0; m < (SL ? 1 : 4); ++m) { bf16_t* rowp = H + (size_t)(row0 + (SL ? sai : ai) * 128 + (SL ? sm : m) * 16) * FF + col0;
                f32x4 h0, h1;
#pragma unroll
                for (int j = 0; j < 4; ++j) { h0[j] = silu_f(acc[ai][0][m][0][j]) * acc[ai][1][m][0][j]; h1[j] = silu_f(acc[ai][0][m][1][j]) * acc[ai][1][m][1][j]; }
                u32x4 w; w.x = cvtpk(h0[0], h0[1]); w.y = cvtpk(h0[2], h0[3]); w.z = cvtpk(h1[0], h1[1]); w.w = cvtpk(h1[2], h1[3]);
                *(u32x4*)rowp = w; }
    }
};
struct EpiIn1 {
    static constexpr bool PERM = false;
    bf16_t* CQ; bf16_t* CKV; bf16_t* KR; float* ssq_q; float* ssq_kv; const f32x2* rope; unsigned* krmax2;
    __device__ __forceinline__ void operator()(AccRef acc, const Unit& u, int wr, int wc, int fr, int fq) const { run<false>(acc, u, wr, wc, fr, fq, 0, 0); }
    template <bool SL> __device__ __forceinline__ void run(AccRef acc, const Unit& u, int wr, int wc, int fr, int fq, int sai, int sm) const {
        const int row0 = u.pm * 256 + wr * 64 + fr;
        if (u.pn < 3) {
            bf16_t* base = (u.pn < 2) ? (CQ + u.pn * 256) : CKV; const int ld = (u.pn < 2) ? 512 : 256; float* ssq = (u.pn < 2) ? ssq_q : ssq_kv;
#pragma unroll
            for (int ai = 0; ai < (SL ? 1 : 2); ++ai)
#pragma unroll
                for (int m = 0; m < (SL ? 1 : 4); ++m) { const int r = row0 + (SL ? sai : ai) * 128 + (SL ? sm : m) * 16; bf16_t* rowp = base + (size_t)r * ld + wc * 32 + 4 * fq; float s = 0.f;
#pragma unroll
                    for (int bj = 0; bj < 2; ++bj)
#pragma unroll
                        for (int n = 0; n < 2; ++n) { const f32x4 x = acc[ai][bj][m][n]; s += (x[0] * x[0] + x[1] * x[1]) + (x[2] * x[2] + x[3] * x[3]); st_bf4(rowp + bj * 128 + n * 16, x); }
                    s += __shfl_xor(s, 16); s += __shfl_xor(s, 32);
                    if (fq == 0) atomicAdd(ssq + r, s); }
        } else if (wc < 2) {
            const bool dorope = u.pm < NLAT / 256; float kmx = 0.f;
#pragma unroll
            for (int ai = 0; ai < (SL ? 1 : 2); ++ai)
#pragma unroll
                for (int m = 0; m < (SL ? 1 : 4); ++m) { const int r = row0 + (SL ? sai : ai) * 128 + (SL ? sm : m) * 16; const int t = r & (SEQ - 1), ang = dorope ? ((wc & 1) ? (t & 63) : (t >> 6)) : 0;
                    f32x4 u1 = acc[ai][0][m][0], u2 = acc[ai][0][m][1];
                    rope4(u1, u2, rope, ang, 4 * fq);
                    { float s = ((u1[0] * u1[0] + u1[1] * u1[1]) + (u1[2] * u1[2] + u1[3] * u1[3])) + ((u2[0] * u2[0] + u2[1] * u2[1]) + (u2[2] * u2[2] + u2[3] * u2[3]));
                      s += __shfl_xor(s, 16); s += __shfl_xor(s, 32); kmx = fmaxf(kmx, s); }
                    bf16_t* rowp = KR + (size_t)r * 64 + wc * 32 + 4 * fq; st_bf4(rowp, u1); st_bf4(rowp + 16, u2); }
            { const int b = u.pm < NLAT / 256 ? (u.pm >> 6) : (u.pm - NLAT / 256);
#pragma unroll
              for (int o = 1; o < 16; o <<= 1) kmx = fmaxf(kmx, __shfl_xor(kmx, o));
              if (fr == 0 && fq == 0) atomicMax(krmax2 + b * 2 + wc, __float_as_uint(kmx)); }
        }
    }
};
struct EpiUQ {
    static constexpr bool PERM = false;
    bf16_t* Q1; const float* ssq_q; const f32x2* rope;
    __device__ __forceinline__ void operator()(AccRef acc, const Unit& u, int wr, int wc, int fr, int fq) const { run<false>(acc, u, wr, wc, fr, fq, 0, 0); }
    template <bool SL> __device__ __forceinline__ void run(AccRef acc, const Unit& u, int wr, int wc, int fr, int fq, int sai, int sm) const {
        const int row0 = u.pm * 256 + wr * 64 + fr;
#pragma unroll
        for (int ai = 0; ai < (SL ? 1 : 2); ++ai)
#pragma unroll
            for (int m = 0; m < (SL ? 1 : 4); ++m) { const int r = row0 + (SL ? sai : ai) * 128 + (SL ? sm : m) * 16; const int t = r & (SEQ - 1), ang = (wc & 1) ? (t & 63) : (t >> 6);
                const float rs = QSC1 / sqrtf(ssq_q[r] * (1.0f / 512.0f) + EPS);
                bf16_t* rowp = Q1 + (size_t)r * 1536 + u.pn * 256 + wc * 32 + 4 * fq;
#pragma unroll
                for (int bj = 0; bj < 2; ++bj) { f32x4 u1 = acc[ai][bj][m][0], u2 = acc[ai][bj][m][1];
                    const int b64 = 4 * u.pn + 2 * bj + (wc >> 1);
                    rope4(u1, u2, rope, (b64 % 3 == 2) ? ang : 0, 4 * fq);
                    st_bf4(rowp + bj * 128, u1 * rs); st_bf4(rowp + bj * 128 + 16, u2 * rs); } if (m == 3) asm volatile("" ::: "memory"); }
    }
};
struct EpiUKV {
    static constexpr bool PERM = true;
    bf16_t* KV1; const float* ssq_kv; unsigned* knmax2;
    bf16_t* VT1;
    LAS unsigned char* scr;
    __device__ __forceinline__ void operator()(AccRef acc, const Unit& u, int wr, int wc, int fr, int fq) const { run<false>(acc, u, wr, wc, fr, fq, 0, 0); }
    template <bool SL> __device__ __forceinline__ void run(AccRef acc, const Unit& u, int wr, int wc, int fr, int fq, int sai, int sm) const {
        const int row0 = u.pm * 256 + wr * 64 + fr, col0 = u.pn * 256 + wc * 32 + 8 * fq; float kmx = 0.f;
#pragma unroll
        for (int ai = 0; ai < (SL ? 1 : 2); ++ai)
#pragma unroll
            for (int m = 0; m < (SL ? 1 : 4); ++m) { const int r = row0 + (SL ? sai : ai) * 128 + (SL ? sm : m) * 16; const float rs = 1.0f / sqrtf(ssq_kv[r] * (1.0f / 256.0f) + EPS);
                bf16_t* rowp = KV1 + (size_t)r * 2048 + col0;
#pragma unroll
                for (int bj = 0; bj < 2; ++bj) { const f32x4 v0 = acc[ai][bj][m][0] * rs, v1 = acc[ai][bj][m][1] * rs;
                    if (bj == 0) { float s = ((v0[0] * v0[0] + v0[1] * v0[1]) + (v0[2] * v0[2] + v0[3] * v0[3])) + ((v1[0] * v1[0] + v1[1] * v1[1]) + (v1[2] * v1[2] + v1[3] * v1[3]));
                        s += __shfl_xor(s, 16); s += __shfl_xor(s, 32); kmx = fmaxf(kmx, s); }
                    if (bj == 0) { u32x4 w; w.x = cvtpk(v0[0], v0[1]); w.y = cvtpk(v0[2], v0[3]); w.z = cvtpk(v1[0], v1[1]); w.w = cvtpk(v1[2], v1[3]);
                        *(u32x4*)rowp = w; }
                    else vt_block(scr + (SL ? wr * 4 + sm : wr * 4 + wc) * 1024, VT1 + (size_t)(u.pn * 128 + wc * 32) * NROW + (r - fr), v0, v1, 8 * fq, 8 * fq + 4, fq * 16 + fr); } asm volatile("" ::: "memory"); }
        { const int b = u.pm < NLAT / 256 ? (u.pm >> 6) : (u.pm - NLAT / 256);
#pragma unroll
          for (int o = 1; o < 16; o <<= 1) kmx = fmaxf(kmx, __shfl_xor(kmx, o));
          if (fr == 0 && fq == 0) atomicMax(knmax2 + (b * 8 + u.pn) * 4 + wc, __float_as_uint(kmx)); }
    }
};
struct EpiMoeDown {
    static constexpr bool PERM = true;
    const bf16_t* src; bf16_t* dst; const float* g2;
    const int* idx; const float* wgt;
    const volatile LAS int* pb; const volatile LAS int* cnt;
    __device__ __forceinline__ void operator()(AccRef acc, const Unit& u, int wr, int wc, int fr, int fq) const { run<false>(acc, u, wr, wc, fr, fq, 0, 0); }
    template <bool SL> __device__ __forceinline__ void run(AccRef acc, const Unit& u, int wr, int wc, int fr, int fq, int sai, int sm) const {
        int e = 0;
#pragma unroll
        for (int k = 1; k < 8; ++k) e += (u.pm >= pb[k]) ? 1 : 0;
        const int lp = u.pm - pb[e], n_e = cnt[e];
        const int col0 = u.pn * 256 + wc * 32 + 8 * fq;
        constexpr int NA = SL ? 1 : 2, NM = SL ? 1 : 4;
        const GAS int* gi = (const GAS int*)idx + (size_t)e * NLAT; const GAS float* gwp = (const GAS float*)wgt + (size_t)e * NLAT;
        const GAS bf16_t* sp = (const GAS bf16_t*)src; GAS bf16_t* dp = (GAS bf16_t*)dst; const GAS float* gp = (const GAS float*)g2 + col0;
        int tok[NA * NM]; float wv[NA * NM];
#pragma unroll
        for (int g = 0; g < NA * NM; ++g) { const int pos = lp * 256 + (SL ? sai : (g >> 2)) * 128 + wr * 64 + (SL ? sm : (g & 3)) * 16 + fr; const bool ok = pos < n_e; const int pc = ok ? pos : 0;
            const int tk = gi[pc]; const float wk = gwp[pc]; tok[g] = ok ? tk : -1; wv[g] = ok ? wk : 0.f; }
        f32x4 gt[2][2][2];
#pragma unroll
        for (int b = 0; b < 2; ++b)
#pragma unroll
            for (int bj = 0; bj < 2; ++bj)
#pragma unroll
                for (int n = 0; n < 2; ++n) gt[b][bj][n] = *(const GAS f32x4*)(gp + b * NMOD + bj * 128 + 4 * n);
#pragma unroll
        for (int ai = 0; ai < NA; ++ai) { u32x4 x[NM][2];
#pragma unroll
            for (int m = 0; m < NM; ++m) { const int t = tok[ai * NM + m]; const size_t ro = (size_t)(t >= 0 ? t : 0) * D + col0;
#pragma unroll
                for (int bj = 0; bj < 2; ++bj) x[m][bj] = *(const GAS u32x4*)(sp + ro + bj * 128); }
#pragma unroll
            for (int m = 0; m < NM; ++m) { const int t = tok[ai * NM + m]; const float w = wv[ai * NM + m]; const bool b1 = (t >> 14) != 0;
                if (t >= 0) { GAS bf16_t* op = dp + (size_t)t * D + col0;
#pragma unroll
                    for (int bj = 0; bj < 2; ++bj) { const f32x4 ga = b1 ? gt[1][bj][0] : gt[0][bj][0], gb = b1 ? gt[1][bj][1] : gt[0][bj][1];
                        const f32x4 r0 = bf4_f(x[m][bj].x, x[m][bj].y) + ga * w * acc[ai][bj][m][0], r1 = bf4_f(x[m][bj].z, x[m][bj].w) + gb * w * acc[ai][bj][m][1];
                        u32x4 o; o.x = cvtpk(r0[0], r0[1]); o.y = cvtpk(r0[2], r0[3]); o.z = cvtpk(r1[0], r1[1]); o.w = cvtpk(r1[2], r1[3]);
                        *(GAS u32x4*)(op + bj * 128) = o; } } }
            asm volatile("" ::: "memory"); }
    }
};
}
namespace att {
constexpr int KVBLK = 64;
constexpr float THRL = 11.5416f;
constexpr int VROW = 144, SHM_V = 128 * VROW;
template <int MODE> struct Cfg;
#ifndef ATT0_LSUM
#define ATT0_LSUM 0
#endif
constexpr int KROW_N = 272, KROW_R = 144, KIMG_N = 64 * KROW_N  , KIMG_R = 64 * KROW_R  ;
template <> struct Cfg<0> { static constexpr bool LSUM = ATT0_LSUM; static constexpr int NQ = 4, NQR = 4, SHM_K = KIMG_N, KRING = 3, PF = 2  ; };
#ifndef ATT1_NQR
#define ATT1_NQR 6
#endif
template <> struct Cfg<1> { static constexpr int NQ = 12, NQR = ATT1_NQR  , SHM_K = KIMG_N + KIMG_R, KRING = 2, PF = 2; static constexpr bool LSUM = false; };
#define SBAR() __builtin_amdgcn_sched_barrier(0)
#ifndef SGB_VALU
#define SGB_VALU 4
#endif
#define SGB_PIPE() do { _Pragma("unroll") for (int _g = 0; _g < 24; ++_g) { __builtin_amdgcn_sched_group_barrier(0x8, 1, 0); __builtin_amdgcn_sched_group_barrier(0x402, SGB_VALU, 0); __builtin_amdgcn_sched_group_barrier(0x100, 2, 0); } } while (0)
__device__ __forceinline__ int crow(int r, int hi) { return (r & 3) + 8 * (r >> 2) + 4 * hi; }
template <int VAR = 0, bool LSUM = false> __device__ __forceinline__ void expA(f32x16& p0, float& l_reg) {
#ifdef ATT_PRIO_EXP
    __builtin_amdgcn_s_setprio(1);
#endif
    if constexpr (VAR != 1) {
#pragma unroll
    for (int r = 0; r < 16; ++r) p0[r] = __builtin_amdgcn_exp2f(p0[r]); }
    if constexpr (!LSUM) { float ps = 0;
#pragma unroll
    for (int r = 0; r < 16; ++r) ps += p0[r];
    l_reg += ps; }
#ifdef ATT_PRIO_EXP
    __builtin_amdgcn_s_setprio(0);
#endif
}
template <int MODE> struct QkFrag { bf16x8 b0, b1, q; };
template <int MODE> __device__ __forceinline__ void qk_load(QkFrag<MODE>& f, int d0, const char* Ks, const bf16x8* qr, const char* qrl, int kn, int kr) {
    if (MODE == 0 || d0 < 8) { f.b0 = *reinterpret_cast<const bf16x8*>(Ks + kn + d0 * 32); f.b1 = *reinterpret_cast<const bf16x8*>(Ks + kn + 32 * KROW_N + d0 * 32); }
    else { f.b0 = *reinterpret_cast<const bf16x8*>(Ks + KIMG_N + kr + (d0 - 8) * 32); f.b1 = *reinterpret_cast<const bf16x8*>(Ks + KIMG_N + kr + 32 * KROW_R + (d0 - 8) * 32); }
    if constexpr (MODE == 1) { if (d0 >= Cfg<1>::NQR) f.q = *reinterpret_cast<const bf16x8*>(qrl + (d0 - Cfg<1>::NQR) * 1024); else f.q = qr[d0]; } else f.q = qr[d0];
}
template <int MODE> __device__ __forceinline__ void qk_pre(QkFrag<MODE>* f, const char* Ks, const bf16x8* qr, const char* qrl, int kn, int kr) {
#pragma unroll
    for (int d0 = 0; d0 < Cfg<MODE>::PF; ++d0) qk_load<MODE>(f[d0], d0, Ks, qr, qrl, kn, kr);
}
template <int MODE> __device__ __forceinline__ void qk_run(f32x16& p0, f32x16& p1, const f32x16& cm, QkFrag<MODE>* f, const char* Ks, const bf16x8* qr, const char* qrl, int kn, int kr) {
    constexpr int NQ = Cfg<MODE>::NQ, PF = Cfg<MODE>::PF;
#pragma unroll
    for (int d0 = 0; d0 < NQ; ++d0) {
        if (d0 + PF < NQ) qk_load<MODE>(f[d0 + PF], d0 + PF, Ks, qr, qrl, kn, kr);
        __builtin_amdgcn_sched_barrier(0x406);
        if (d0 == 0) { p0 = __builtin_amdgcn_mfma_f32_32x32x16_bf16(f[0].b0, f[0].q, cm, 0, 0, 0); p1 = __builtin_amdgcn_mfma_f32_32x32x16_bf16(f[0].b1, f[0].q, cm, 0, 0, 0); }
        else { p0 = __builtin_amdgcn_mfma_f32_32x32x16_bf16(f[d0].b0, f[d0].q, p0, 0, 0, 0); p1 = __builtin_amdgcn_mfma_f32_32x32x16_bf16(f[d0].b1, f[d0].q, p1, 0, 0, 0); }
        __builtin_amdgcn_sched_barrier(0x406);
    }
}
template <int MODE> __device__ __forceinline__ void qkt(f32x16& p0, f32x16& p1, const f32x16& cm, const char* Ks, const bf16x8* qr, const char* qrl, int kn, int kr) {
    QkFrag<MODE> f[Cfg<MODE>::NQ]; qk_pre<MODE>(f, Ks, qr, qrl, kn, kr); qk_run<MODE>(p0, p1, cm, f, Ks, qr, qrl, kn, kr);
}
__device__ __forceinline__ int v_st(int k, int c) { const int kk = (k & ~0xC) | ((k & 4) << 1) | ((k & 8) >> 1); return ((kk >> 3) * 4 + (c >> 5)) * 512 + ((kk & 7) * 32 + (c & 31)) * 2; }
__device__ __forceinline__ int v_rd_base(int lane) { return ((lane & 3) << 3) | (((lane >> 2) & 3) << 6) | (((lane >> 4) & 1) << 5) | (((lane >> 5) & 1) << 8); }
constexpr int v_rd_off(int d0, int ks, int half) { return d0 * 512 + ks * 4096 + half * 2048; }
template <int OFF> __device__ __forceinline__ s16x4 tr_read(int vb) {
    s16x4 r; asm volatile("ds_read_b64_tr_b16 %0, %1 offset:%2" : "=&v"(r) : "v"(vb), "i"(OFF) : "memory"); return r;
}
template <int KS, int VAR = 0, bool LSUM = false> __device__ __forceinline__ void pv_ks(f32x16* o, const char* vp, const f32x16& p) {
    static_assert(!LSUM, "row sums by MFMA are not available in the transposed form");
    constexpr int B = 8 * (KS & 1);
    const bf16x8 v0 = *reinterpret_cast<const bf16x8*>(vp + 0 * 32 * VROW + KS * 32), v1 = *reinterpret_cast<const bf16x8*>(vp + 1 * 32 * VROW + KS * 32);
    const bf16x8 v2 = *reinterpret_cast<const bf16x8*>(vp + 2 * 32 * VROW + KS * 32), v3 = *reinterpret_cast<const bf16x8*>(vp + 3 * 32 * VROW + KS * 32);
    bf16x8 pb;
    { u32x4 w = {cvtpk(p[B + 0], p[B + 1]), cvtpk(p[B + 2], p[B + 3]), cvtpk(p[B + 4], p[B + 5]), cvtpk(p[B + 6], p[B + 7])}; pb = *reinterpret_cast<bf16x8*>(&w); }
    if constexpr (VAR == 6) { asm volatile("" :: "v"(pb), "v"(v0), "v"(v1), "v"(v2), "v"(v3)); } else {
    o[0] = __builtin_amdgcn_mfma_f32_32x32x16_bf16(v0, pb, o[0], 0, 0, 0);
    o[1] = __builtin_amdgcn_mfma_f32_32x32x16_bf16(v1, pb, o[1], 0, 0, 0);
    o[2] = __builtin_amdgcn_mfma_f32_32x32x16_bf16(v2, pb, o[2], 0, 0, 0);
    o[3] = __builtin_amdgcn_mfma_f32_32x32x16_bf16(v3, pb, o[3], 0, 0, 0); }
}
template <int VAR = 0, bool LSUM = false> __device__ __forceinline__ void pv_all(f32x16* o, const char* vp, const f32x16& p0, const f32x16& p1) {
    pv_ks<0, VAR, LSUM>(o, vp, p0); pv_ks<1, VAR, LSUM>(o, vp, p0); pv_ks<2, VAR, LSUM>(o, vp, p1); pv_ks<3, VAR, LSUM>(o, vp, p1);
}

template <int VAR = 0> __device__ __forceinline__ void pv_all_pre(f32x16* o, const char* vp, const f32x16& p0, const f32x16& p1, const bf16x8 (&vf)[4]) {
    bf16x8 pb;
    { u32x4 w = {cvtpk(p0[0], p0[1]), cvtpk(p0[2], p0[3]), cvtpk(p0[4], p0[5]), cvtpk(p0[6], p0[7])}; pb = *reinterpret_cast<bf16x8*>(&w); }
#pragma unroll
    for (int d = 0; d < 4; ++d) o[d] = __builtin_amdgcn_mfma_f32_32x32x16_bf16(vf[d], pb, o[d], 0, 0, 0);
    pv_ks<1, VAR, false>(o, vp, p0); pv_ks<2, VAR, false>(o, vp, p1); pv_ks<3, VAR, false>(o, vp, p1);
}
#define ATT_VPRE(vf, vp) do { _Pragma("unroll") for (int _d = 0; _d < 4; ++_d) (vf)[_d] = *reinterpret_cast<const bf16x8*>((vp) + _d * 32 * VROW); } while (0)
template <int MODE, int VAR = 0>
__device__ __forceinline__ void attn_unit(const bf16_t* __restrict__ Qw, const bf16_t* __restrict__ Kg, const bf16_t* __restrict__ Vg, const bf16_t* __restrict__ KRg,
                                          int lat0, int nlt, int ctx0, int NT, bf16_t* __restrict__ Od, int orow0, float lam, const float* __restrict__ kb2, const float* __restrict__ kb2r,
                                          char* lds, LAS unsigned char* ldsl) {
    using C = Cfg<MODE>; constexpr int NQ = C::NQ, SHM_K = C::SHM_K;
    const int tid = opaque_tid(), wid = tid >> 6, lane = tid & 63, r32 = lane & 31, hi = lane >> 5;
    const int wu = __builtin_amdgcn_readfirstlane(wid);
    constexpr int VRING = C::KRING;
    char* V_lds = lds; char* K_lds = lds + VRING * SHM_V;
    constexpr int KRING = C::KRING;
    float* ws = (float*)(lds + VRING * SHM_V + KRING * SHM_K) + wid * 64; float* li_l = ws;
    float l_reg = 0; f32x16 o[4] = {}; bf16x8 qr[C::NQR];
    char* qrl = lds + VRING * SHM_V + KRING * SHM_K + 2048 + (wid * (NQ - C::NQR) * 64 + lane) * 16;
    float mrow = 0.f;
#pragma unroll
    for (int blk = 0; blk < NQ / 2; ++blk) { float s2 = 0.f;
#pragma unroll
        for (int dd = 0; dd < 2; ++dd) { const int d0 = 2 * blk + dd; const bf16x8 q = *reinterpret_cast<const bf16x8*>(Qw + d0 * 16);
#pragma unroll
            for (int j = 0; j < 8; ++j) { const float x = __uint_as_float(((unsigned)(unsigned short)q[j]) << 16); s2 += x * x; }
            if constexpr (MODE == 1) { if (d0 >= C::NQR) *reinterpret_cast<bf16x8*>(qrl + (d0 - C::NQR) * 1024) = q; else qr[d0] = q; } else qr[d0] = q; }
        s2 += __shfl_xor(s2, 32);
        float k2;
        if constexpr (MODE == 0) k2 = kb2[(wid >> 2) * 2 + blk]; else k2 = (blk < 4) ? kb2[blk] : kb2r[blk - 4];
        mrow += sqrtf(s2 * k2); }
    mrow = mrow * 1.01f + 1e-3f;
    f32x16 cm;
#pragma unroll
    for (int r = 0; r < 16; ++r) cm[r] = -mrow;
    const int kn = r32 * KROW_N + ((MODE == 0) ? (wid >> 2) * 128 : 0) + hi * 16, kr = r32 * KROW_R + hi * 16;
    const char* vp0 = V_lds + r32 * VROW + hi * 16;
    constexpr int KSTR = (MODE == 0) ? 768 : 2048;
    unsigned vsrc[3], ksrc[3], rsrc[2] = {0u, 0u};
#pragma unroll
    for (int i = 0; i < 3; ++i) { const int L = 1024 * (wid + 8 * i) + 16 * lane, col = (L / VROW) & 127, x = L - (L / VROW) * VROW; vsrc[i] = (unsigned)col * (unsigned)(NROW * 2) + (unsigned)(x < 128 ? x : 0); }
#pragma unroll
    for (int i = 0; i < 3; ++i) { const int L = 1024 * (wid + 8 * i) + 16 * lane, row = (L / KROW_N) & 63, x = L - (L / KROW_N) * KROW_N; ksrc[i] = (unsigned)(row * KSTR) * 2u + (unsigned)(x < 256 ? x : 0); }
    if constexpr (MODE == 1) {
#pragma unroll
        for (int i = 0; i < 2; ++i) { const int L = 1024 * (wid + 8 * i) + 16 * lane, row = (L / KROW_R) & 63, x = L - (L / KROW_R) * KROW_R; rsrc[i] = (unsigned)(row * 64) * 2u + (unsigned)(x < 128 ? x : 0); } }
    const unsigned pw = 1024u * (unsigned)wu;
#define TROW(j) ((j) < nlt ? lat0 + (j) * KVBLK : ctx0 + ((j) - nlt) * KVBLK)
#define DMA16(gp, loff) if constexpr (VAR != 3) __builtin_amdgcn_global_load_lds((const unsigned*)(gp), (LAS unsigned*)(ldsl + (loff)), 16, 0, 0)
#define LOADK(j, koff) do { const size_t _r = (size_t)TROW(j); const char* _kb = (const char*)(Kg + _r * KSTR); const unsigned _kl = VRING * SHM_V + (unsigned)(koff); \
    DMA16(_kb + ksrc[0], _kl + pw); DMA16(_kb + ksrc[1], _kl + 8192 + pw); if (wu == 0) DMA16(_kb + ksrc[2], _kl + 16384); \
    if constexpr (MODE == 1) { const char* _rb = (const char*)(KRg + _r * 64); DMA16(_rb + rsrc[0], _kl + KIMG_N + pw); if (wu == 0) DMA16(_rb + rsrc[1], _kl + KIMG_N + 8192); } } while (0)
#define LOADV(j, voff) do { const char* _vb = (const char*)Vg + (size_t)TROW(j) * 2; \
    DMA16(_vb + vsrc[0], (unsigned)(voff) + pw); DMA16(_vb + vsrc[1], (unsigned)(voff) + 8192 + pw); if (wu < 2) DMA16(_vb + vsrc[2], (unsigned)(voff) + 16384 + pw); } while (0)
#define SYNC() do { asm volatile("s_waitcnt vmcnt(0) lgkmcnt(0)" ::: "memory"); if constexpr (VAR != 2) __builtin_amdgcn_s_barrier(); asm volatile("" ::: "memory"); } while (0)
#define SYNCK() do { if constexpr (KRING == 3) { if constexpr (MODE == 0) asm volatile("s_waitcnt vmcnt(4) lgkmcnt(0)" ::: "memory"); else asm volatile("s_waitcnt vmcnt(5) lgkmcnt(0)" ::: "memory"); } \
    else asm volatile("s_waitcnt vmcnt(0) lgkmcnt(0)" ::: "memory"); if constexpr (VAR != 2) __builtin_amdgcn_s_barrier(); asm volatile("" ::: "memory"); } while (0)
    f32x16 pA0, pA1, pB0, pB1;
    if constexpr (KRING == 2) {
    LOADK(0, 0); LOADV(0, 0); LOADK(1, SHM_K); SYNC();
    if constexpr (VAR != 5) qkt<MODE>(pA0, pA1, cm, K_lds, qr, qrl, kn, kr); expA<VAR, C::LSUM>(pA0, l_reg); SYNC();
    for (int j = 0; j + 2 < NT; j += 2) {
        LOADK(j + 2, 0); LOADV(j + 1, SHM_V);
        { QkFrag<MODE> kf[NQ]; SBAR(); if constexpr (VAR != 5) qk_pre<MODE>(kf, K_lds + SHM_K, qr, qrl, kn, kr); SBAR(); expA<VAR, C::LSUM>(pA1, l_reg); if constexpr (VAR != 5) qk_run<MODE>(pB0, pB1, cm, kf, K_lds + SHM_K, qr, qrl, kn, kr); SBAR(); }
        if constexpr (VAR != 4) pv_all<VAR, C::LSUM>(o, vp0, pA0, pA1); expA<VAR, C::LSUM>(pB0, l_reg);
        SYNC();
        LOADK(j + 3, SHM_K); LOADV(j + 2, 0);
        { QkFrag<MODE> kf[NQ]; SBAR(); if constexpr (VAR != 5) qk_pre<MODE>(kf, K_lds, qr, qrl, kn, kr); SBAR(); expA<VAR, C::LSUM>(pB1, l_reg); if constexpr (VAR != 5) qk_run<MODE>(pA0, pA1, cm, kf, K_lds, qr, qrl, kn, kr); SBAR(); }
        if constexpr (VAR != 4) pv_all<VAR, C::LSUM>(o, vp0 + SHM_V, pB0, pB1); expA<VAR, C::LSUM>(pA0, l_reg);
        SYNC();
    }
    LOADV(NT - 1, SHM_V);
    { QkFrag<MODE> kf[NQ]; SBAR(); if constexpr (VAR != 5) qk_pre<MODE>(kf, K_lds + SHM_K, qr, qrl, kn, kr); SBAR(); expA<VAR, C::LSUM>(pA1, l_reg); if constexpr (VAR != 5) qk_run<MODE>(pB0, pB1, cm, kf, K_lds + SHM_K, qr, qrl, kn, kr); SBAR(); }
    if constexpr (VAR != 4) pv_all<VAR, C::LSUM>(o, vp0, pA0, pA1); expA<VAR, C::LSUM>(pB0, l_reg);
    SYNC();
    expA<VAR, C::LSUM>(pB1, l_reg);
    if constexpr (VAR != 4) pv_all<VAR, C::LSUM>(o, vp0 + SHM_V, pB0, pB1);
    } else {
    LOADK(0, 0); LOADV(0, 0); LOADK(1, SHM_K); LOADV(1, SHM_V); LOADK(2, 2 * SHM_K); SYNC();
    if constexpr (VAR != 5) qkt<MODE>(pA0, pA1, cm, K_lds, qr, qrl, kn, kr); expA<VAR, C::LSUM>(pA0, l_reg); SYNC();
    int k0 = 0, k1 = SHM_K, k2 = 2 * SHM_K;
    int v0 = 0, v1 = SHM_V, v2 = 2 * SHM_V;
    for (int j = 0; j + 2 < NT; j += 2) {
        LOADV(j + 2, v2); LOADK((j + 3 < NT) ? j + 3 : NT - 1, k0);
        { QkFrag<MODE> kf[NQ]; bf16x8 vf[4]; SBAR(); if constexpr (VAR != 5) qk_pre<MODE>(kf, K_lds + k1, qr, qrl, kn, kr); ATT_VPRE(vf, vp0 + v0); SBAR(); expA<VAR, C::LSUM>(pA1, l_reg); if constexpr (VAR != 5) qk_run<MODE>(pB0, pB1, cm, kf, K_lds + k1, qr, qrl, kn, kr); SBAR();
          if constexpr (VAR != 4) pv_all_pre<VAR>(o, vp0 + v0, pA0, pA1, vf); } expA<VAR, C::LSUM>(pB0, l_reg);
        SYNCK();
        LOADV((j + 3 < NT) ? j + 3 : NT - 1, v0); LOADK((j + 4 < NT) ? j + 4 : NT - 1, k1);
        { QkFrag<MODE> kf[NQ]; bf16x8 vf[4]; SBAR(); if constexpr (VAR != 5) qk_pre<MODE>(kf, K_lds + k2, qr, qrl, kn, kr); ATT_VPRE(vf, vp0 + v1); SBAR(); expA<VAR, C::LSUM>(pB1, l_reg); if constexpr (VAR != 5) qk_run<MODE>(pA0, pA1, cm, kf, K_lds + k2, qr, qrl, kn, kr); SBAR();
          if constexpr (VAR != 4) pv_all_pre<VAR>(o, vp0 + v1, pB0, pB1, vf); } expA<VAR, C::LSUM>(pA0, l_reg);
        SYNCK();
        { const int t = k0; k0 = k2; k2 = k1; k1 = t; }
        { const int t = v0; v0 = v2; v2 = v1; v1 = t; }
    }
    SYNC();
    { QkFrag<MODE> kf[NQ]; SBAR(); if constexpr (VAR != 5) qk_pre<MODE>(kf, K_lds + k1, qr, qrl, kn, kr); SBAR(); expA<VAR, C::LSUM>(pA1, l_reg); if constexpr (VAR != 5) qk_run<MODE>(pB0, pB1, cm, kf, K_lds + k1, qr, qrl, kn, kr); SBAR(); }
    if constexpr (VAR != 4) pv_all<VAR, C::LSUM>(o, vp0 + v0, pA0, pA1); expA<VAR, C::LSUM>(pB0, l_reg);
    expA<VAR, C::LSUM>(pB1, l_reg);
    if constexpr (VAR != 4) pv_all<VAR, C::LSUM>(o, vp0 + v1, pB0, pB1);
    }
    l_reg += __shfl_xor(l_reg, 32);
    static_assert(!C::LSUM, "");
    const float rl = __builtin_amdgcn_rcpf(l_reg);
#define ATT_STORE_ROW(SC) do { bf16_t* Ow = Od + (size_t)(orow0 + (wid & (MODE == 0 ? 3 : 7)) * 32 + r32) * D + 8 * hi; \
        _Pragma("unroll") for (int d0 = 0; d0 < 4; ++d0) \
            _Pragma("unroll") for (int m = 0; m < 2; ++m) { \
                unsigned a0 = cvtpk(o[d0][8 * m + 0] * (SC), o[d0][8 * m + 1] * (SC)), a1 = cvtpk(o[d0][8 * m + 2] * (SC), o[d0][8 * m + 3] * (SC)); \
                unsigned b0 = cvtpk(o[d0][8 * m + 4] * (SC), o[d0][8 * m + 5] * (SC)), b1 = cvtpk(o[d0][8 * m + 6] * (SC), o[d0][8 * m + 7] * (SC)); \
                auto r0 = __builtin_amdgcn_permlane32_swap(a0, b0, false, false); auto r1 = __builtin_amdgcn_permlane32_swap(a1, b1, false, false); \
                u32x4 w = {r0[0], r1[0], r0[1], r1[1]}; *reinterpret_cast<u32x4*>(Ow + d0 * 32 + m * 16) = w; } } while (0)
    if constexpr (MODE == 1) {
        ATT_STORE_ROW(rl);
        __syncthreads();
    } else {
        float* X = (float*)lds;
#pragma unroll
        for (int d0 = 0; d0 < 4; ++d0)
#pragma unroll
            for (int r = 0; r < 16; ++r) o[d0][r] *= rl;
        __syncthreads();
        if (wid >= 4) {
#pragma unroll
            for (int d0 = 0; d0 < 4; ++d0)
#pragma unroll
                for (int r = 0; r < 16; ++r) X[((wid - 4) * 64 + d0 * 16 + r) * 64 + lane] = o[d0][r];
        }
        __syncthreads();
        if (wid < 4) {
            float ss = 0.f;
#pragma unroll
            for (int d0 = 0; d0 < 4; ++d0)
#pragma unroll
                for (int r = 0; r < 16; ++r) { const float a = o[d0][r] - lam * X[(wid * 64 + d0 * 16 + r) * 64 + lane]; o[d0][r] = a; ss += a * a; }
            ss += __shfl_xor(ss, 32);
            const float rs = (1.0f - LAM_INIT0) / sqrtf(ss * (1.0f / 128.0f) + EPS);
            ATT_STORE_ROW(rs);
        }
        __syncthreads();
    }
#undef ATT_STORE_ROW
#undef TROW
#undef DMA16
#undef LOADK
#undef LOADV
#undef SYNC
#undef SYNCK
}
}
struct Args { const float* in[30]; float* out; unsigned char* ws; int ph_lo, ph_hi; };
enum { I_X = 0, I_C, I_CTX, I_CCTX, I_N1G, I_N2G, I_MODW, I_MODB, I_EWIN, I_POOLW, I_POOLS, I_LQ1, I_LK1, I_LQ2, I_LK2, I_EWOUT, I_FG, I_FU, I_FD,
       I_OWIN, I_QNG, I_KVNG, I_WUQ, I_WUKV, I_OWOUT, I_RTW, I_MG, I_MU, I_MD, I_FNG };

__device__ __forceinline__ void tr_load(const float* W, int N, int k0, int n0, const float* ksc, LAS float* scr, int lane) {
    float v[32];
#pragma unroll
    for (int i = 0; i < 32; ++i) v[i] = W[(size_t)(k0 + 2 * i + (lane >> 5)) * N + n0 + (lane & 31)];
    if (ksc) {
#pragma unroll
        for (int i = 0; i < 32; ++i) v[i] *= ksc[k0 + 2 * i + (lane >> 5)]; }
#pragma unroll
    for (int i = 0; i < 32; ++i) scr[(2 * i + (lane >> 5)) * 33 + (lane & 31)] = v[i];
    LDS_WAIT(); asm volatile("" ::: "memory");
}
__device__ __forceinline__ void tr_store(bf16_t* drow0, int ldk, int k0, LAS float* scr, int lane) {
    const int c = lane & 7;
#pragma unroll
    for (int j = 0; j < 4; ++j) { const int n = (lane >> 3) + 8 * j; const LAS float* s = scr + (8 * c) * 33 + n;
        u32x4 o; o.x = pk2(s[0 * 33], s[1 * 33]); o.y = pk2(s[2 * 33], s[3 * 33]); o.z = pk2(s[4 * 33], s[5 * 33]); o.w = pk2(s[6 * 33], s[7 * 33]);
        *(u32x4*)(drow0 + (size_t)n * ldk + k0 + 8 * c) = o; }
    LDS_WAIT(); asm volatile("" ::: "memory");
}
__device__ __forceinline__ void tr_item(const float* W, int N, int it, const float* ksc, bf16_t* dst, int ldk, int rowmode, LAS float* scr, int lane) {
    const int nblk = N / 32, kb = it / nblk, nb = it - kb * nblk, k0 = 64 * kb, n0 = 32 * nb;
    const int drow0 = rowmode == 0 ? n0 : (256 * (n0 >> 7) + (n0 & 127) + (rowmode == 2 ? 128 : 0));
    tr_load(W, N, k0, n0, ksc, scr, lane);
    tr_store(dst + (size_t)drow0 * ldk, ldk, k0, scr, lane);
}
__device__ __forceinline__ void tr_item_fold(const float* W, const float* pw, const float* ps, int it, bf16_t* dst, LAS float* scr, int lane) {
    const int g = it / 32, nb = it - g * 32, k0 = 64 * g, n0 = 32 * nb, n = lane & 31, half = lane >> 5;
    tr_load(W, D, k0, n0, nullptr, scr, lane);
    float acc[32];
#pragma unroll
    for (int i = 0; i < 32; ++i) acc[i] = 0.f;
    for (int e = 0; e < 64; ++e) { const float x = scr[e * 33 + n] * ps[k0 + e];
#pragma unroll
        for (int i = 0; i < 32; ++i) acc[i] += pw[(size_t)(k0 + 2 * i + half) * 64 + e] * x; }
    LDS_WAIT(); asm volatile("" ::: "memory");
#pragma unroll
    for (int i = 0; i < 32; ++i) scr[(2 * i + half) * 33 + n] = acc[i];
    LDS_WAIT(); asm volatile("" ::: "memory");
    tr_store(dst + (size_t)n0 * D, D, k0, scr, lane);
}

__device__ __forceinline__ void norm_mod_row(const float* __restrict__ hrow, const float* __restrict__ g, const float* __restrict__ sh, const float* __restrict__ sc, bf16_t* __restrict__ orow, int lane, f32x4 (&a)[4]) {
    const f32x4* xr = (const f32x4*)hrow + lane; float s = 0.f; f32x4 gv[4], sv[4], cv[4];
#pragma unroll
    for (int j = 0; j < 4; ++j) a[j] = xr[64 * j];
#pragma unroll
    for (int j = 0; j < 4; ++j) { gv[j] = ((const f32x4*)g)[64 * j + lane]; sv[j] = ((const f32x4*)sh)[64 * j + lane]; cv[j] = ((const f32x4*)sc)[64 * j + lane]; }
#pragma unroll
    for (int j = 0; j < 4; ++j) s += (a[j][0] * a[j][0] + a[j][1] * a[j][1]) + (a[j][2] * a[j][2] + a[j][3] * a[j][3]);
    const float r = 1.0f / sqrtf(wave_sum(s) * (1.0f / D) + EPS);
    u32x2* o8 = (u32x2*)orow + lane; u32x2 w[4];
#pragma unroll
    for (int j = 0; j < 4; ++j) { a[j] = (a[j] * r) * gv[j] * (1.0f + cv[j]) + sv[j]; w[j].x = cvtpk(a[j][0], a[j][1]); w[j].y = cvtpk(a[j][2], a[j][3]); }
#pragma unroll
    for (int j = 0; j < 4; ++j) o8[64 * j] = w[j];
}
template <bool BF, int NR> __device__ __forceinline__ void norm_rowsN(const char* __restrict__ h, const f32x4 (&gs)[4], const f32x4 (&sv)[4], bf16_t* __restrict__ o, int lane) {
    constexpr size_t RB = BF ? 2 * D : 4 * D;
    f32x4 a[NR][4]; float ss[NR];
    if constexpr (BF) { u32x2 raw[NR][4];
#pragma unroll
        for (int q = 0; q < NR; ++q)
#pragma unroll
            for (int j = 0; j < 4; ++j) raw[q][j] = ((const u32x2*)(h + q * RB) + lane)[64 * j];
#pragma unroll
        for (int q = 0; q < NR; ++q)
#pragma unroll
            for (int j = 0; j < 4; ++j) a[q][j] = epi::bf4_f(raw[q][j].x, raw[q][j].y); }
    else {
#pragma unroll
        for (int q = 0; q < NR; ++q)
#pragma unroll
            for (int j = 0; j < 4; ++j) a[q][j] = ((const f32x4*)(h + q * RB) + lane)[64 * j]; }
#pragma unroll
    for (int q = 0; q < NR; ++q) { float s = 0.f;
#pragma unroll
        for (int j = 0; j < 4; ++j) s += (a[q][j][0] * a[q][j][0] + a[q][j][1] * a[q][j][1]) + (a[q][j][2] * a[q][j][2] + a[q][j][3] * a[q][j][3]);
        ss[q] = s; }
#pragma unroll
    for (int x = 1; x < 64; x <<= 1)
#pragma unroll
        for (int q = 0; q < NR; ++q) ss[q] += __shfl_xor(ss[q], x);
#pragma unroll
    for (int q = 0; q < NR; ++q) { const float r = 1.0f / sqrtf(ss[q] * (1.0f / D) + EPS); u32x2* p = (u32x2*)(o + (size_t)q * D) + lane;
#pragma unroll
        for (int j = 0; j < 4; ++j) { const f32x4 y = (a[q][j] * r) * gs[j] + sv[j]; u32x2 w; w.x = cvtpk(y[0], y[1]); w.y = cvtpk(y[2], y[3]); p[64 * j] = w; } }
}
template <bool BF> __device__ __forceinline__ void norm_phase(const void* hl, const void* hc, const float* ng, const float* modl, int ch, bf16_t* A, int nrows, int gw, int ngw, int lane) {
    constexpr size_t RB = BF ? 2 * D : 4 * D;
    f32x4 gv[4], gs[4], sv[4];
#pragma unroll
    for (int j = 0; j < 4; ++j) gv[j] = ((const f32x4*)ng)[64 * j + lane];
    for (int r0 = gw * 16; r0 < NLAT; r0 += ngw * 16) {
        const float* mv = modl + (r0 >> 14) * NMOD;
#pragma unroll
        for (int j = 0; j < 4; ++j) { gs[j] = gv[j] * (((const f32x4*)(mv + (ch + 1) * D))[64 * j + lane] + 1.0f); sv[j] = ((const f32x4*)(mv + ch * D))[64 * j + lane]; }
        for (int q = 0; q < 16; q += 4) norm_rowsN<BF, 4>((const char*)hl + (size_t)(r0 + q) * RB, gs, sv, A + (size_t)(r0 + q) * D, lane);
    }
    if (nrows > NLAT && NLAT + gw < nrows) {
        const float* mv = modl + 2 * NMOD;
#pragma unroll
        for (int j = 0; j < 4; ++j) { gs[j] = gv[j] * (((const f32x4*)(mv + (ch + 1) * D))[64 * j + lane] + 1.0f); sv[j] = ((const f32x4*)(mv + ch * D))[64 * j + lane]; }
        for (int r = NLAT + gw; r < nrows; r += ngw) norm_rowsN<BF, 1>((const char*)hc + (size_t)(r - NLAT) * RB, gs, sv, A + (size_t)r * D, lane);
    }
}

__global__ void __launch_bounds__(NTHR, 2) fwd_kernel(Args args) {
    extern __shared__ __attribute__((aligned(16))) unsigned char lds[];
    LAS unsigned char* ldsl = (LAS unsigned char*)lds;
    volatile LAS unsigned* MISC = (volatile LAS unsigned*)(ldsl + MISC_OFF);
    const int wave = __builtin_amdgcn_readfirstlane(threadIdx.x >> 6);
    const int G = gridDim.x, bx = blockIdx.x, gw = bx * NW + wave, ngw = G * NW;
    unsigned* ctl0 = (unsigned*)(args.ws + WS_CTL);
    for (int u = threadIdx.x; u < (LDS_BYTES - MISC_OFF) / 4; u += NTHR) MISC[u] = 0u;
    __syncthreads();
    XcdBarrier bar = xcd_barrier_post(ctl0 + CW_BAR, MISC);
    const int lo = args.ph_lo, hi_ = args.ph_hi;
#define PHASE_PTRS unsigned char* ws = args.ws; asm volatile("" : "+s"(ws)); float* OUT = args.out; asm volatile("" : "+s"(OUT)); unsigned* ctl = (unsigned*)(ws + WS_CTL); float* modv = (float*)(ws + WS_TAB); f32x2* rope = (f32x2*)(ws + WS_TAB + TAB_ROPE); int* midx = (int*)(ws + WS_TAB + TAB_IDX); float* mwgt = (float*)(ws + WS_TAB + TAB_WGT); float* ssq_q = (float*)(ws + CTL_SSQQ); float* ssq_kv = (float*)(ws + CTL_SSQKV); unsigned* kmax2 = (unsigned*)(ws + 65536); unsigned* knmax2 = (unsigned*)(ws + 65536 + 1024); unsigned* krmax2 = (unsigned*)(ws + 65536 + 2048); bf16_t* HC = (bf16_t*)(ws + WS_HC); bf16_t* HS = (bf16_t*)(OUT + (size_t)NLAT * D / 2); (void)HS; bf16_t* Wb = (bf16_t*)(ws + WS_W); bf16_t* Abuf = (bf16_t*)(ws + WS_A); unsigned char* big = ws + WS_BIG; (void)ctl; (void)modv; (void)rope; (void)midx; (void)mwgt; (void)ssq_q; (void)ssq_kv; (void)kmax2; (void)knmax2; (void)krmax2; (void)HC; (void)Wb; (void)Abuf; (void)big; (void)OUT;
#define INP(i) ({ int _i = (i); asm volatile("" : "+s"(_i)); args.in[_i]; })
#ifndef ONLY_PHASE
#define ONLY_PHASE -1
#endif
#ifndef REPEAT_PHASE
#define REPEAT_PHASE -1
#endif
#define IN(k) ((ONLY_PHASE < 0 || ONLY_PHASE == (k)) && lo <= (k) && (k) < hi_)
#ifndef REPN
#define REPN 2
#endif
#define REP(k) for (int rep_ = 0; rep_ < ((REPEAT_PHASE == (k)) ? REPN : 1); ++rep_)
#define SEAM(k) do { if (IN(k) && IN((k) + 1)) xcd_barrier(bar); } while (0)

    constexpr int N_IN0 = 16 * 80, N_OUT0 = 16 * 32, N_G0 = 16 * 88, N_D0 = 44 * 32, N_IN1 = 16 * 26, N_Z1 = 192, N_UQ = 8 * 48, N_UKV = 4 * 64, N_OUT1 = 16 * 32;
    constexpr int NITEMS = N_IN0 + N_OUT0 + 2 * N_G0 + N_D0 + N_IN1 + N_Z1 + N_UQ + N_UKV + N_OUT1;
#define LAYER_WCONV(lo_, hi_i) do { LAS float* scr = (LAS float*)(ldsl + wave * 16384); \
        for (int it = (lo_) + gw; it < (hi_i); it += ngw) { \
            int r = it; \
            if (r < N_IN0) { tr_item(INP(I_EWIN), 2560, r, nullptr, Wb + W_IN0 / 2, D, 0, scr, lane); continue; } r -= N_IN0; \
            if (r < N_OUT0) { if (r < 128) tr_item_fold(INP(I_EWOUT), INP(I_POOLW), INP(I_POOLS), r, Wb + W_OUT0 / 2, scr, lane); \
                              else tr_item(INP(I_EWOUT), D, r, nullptr, Wb + W_OUT0 / 2, D, 0, scr, lane); continue; } r -= N_OUT0; \
            if (r < N_G0) { tr_item(INP(I_FG), FF, r, nullptr, Wb + W_GU0 / 2, D, 1, scr, lane); continue; } r -= N_G0; \
            if (r < N_G0) { tr_item(INP(I_FU), FF, r, nullptr, Wb + W_GU0 / 2, D, 2, scr, lane); continue; } r -= N_G0; \
            if (r < N_D0) { tr_item(INP(I_FD), D, r, nullptr, Wb + W_DN0 / 2, FF, 0, scr, lane); continue; } r -= N_D0; \
            if (r < N_IN1) { tr_item(INP(I_OWIN), 832, r, nullptr, Wb + W_IN1 / 2, D, 0, scr, lane); continue; } r -= N_IN1; \
            if (r < N_Z1) { u32x4* z = (u32x4*)(Wb + W_IN1 / 2 + (size_t)(832 + r) * D); z[lane] = (u32x4){0u, 0u, 0u, 0u}; z[64 + lane] = (u32x4){0u, 0u, 0u, 0u}; continue; } r -= N_Z1; \
            if (r < N_UQ) { tr_item(INP(I_WUQ), 1536, r, INP(I_QNG), Wb + W_UQ / 2, 512, 0, scr, lane); continue; } r -= N_UQ; \
            if (r < N_UKV) { tr_item(INP(I_WUKV), 2048, r, INP(I_KVNG), Wb + W_UKV / 2, 256, 0, scr, lane); continue; } r -= N_UKV; \
            tr_item(INP(I_OWOUT), D, r, nullptr, Wb + W_OUT1 / 2, D, 0, scr, lane); } } while (0)
    asm volatile("; ===PHASE 0");
    REP(0) if (IN(0)) { const int tid = opaque_tid(), lane = tid & 63; (void)tid; (void)lane; PHASE_PTRS
        if (bx < 192) {
            const int i = bx / 96, n = (bx % 96) * 64 + lane; const float* mw = INP(I_MODW) + (size_t)i * D * NMOD + n;
            const float* c0 = INP(I_C), *c1 = INP(I_C) + D, *c2 = INP(I_CCTX);
            LAS float* sil = (LAS float*)ldsl + 2048;
            for (int e = tid; e < 3 * D; e += NTHR) { const int v = e >> 10, k = e & (D - 1); const float x = (v == 0) ? c0[k] : (v == 1) ? c1[k] : c2[k]; sil[e] = x / (1.0f + expf(-x)); }
            __syncthreads();
            float a0 = 0.f, a1 = 0.f, a2 = 0.f;
            for (int kk = 0; kk < 128; kk += 16) { float w[16];
#pragma unroll
                for (int q = 0; q < 16; ++q) w[q] = mw[(size_t)(wave * 128 + kk + q) * NMOD];
#pragma unroll
                for (int q = 0; q < 16; ++q) { const int k = wave * 128 + kk + q; a0 += sil[k] * w[q]; a1 += sil[D + k] * w[q]; a2 += sil[2 * D + k] * w[q]; } }
            LAS float* red = (LAS float*)ldsl;
            red[(wave * 3 + 0) * 64 + lane] = a0; red[(wave * 3 + 1) * 64 + lane] = a1; red[(wave * 3 + 2) * 64 + lane] = a2;
            __syncthreads();
            if (wave < 3) { float s = INP(I_MODB)[i * NMOD + n];
#pragma unroll
                for (int w = 0; w < 8; ++w) s += red[(w * 3 + wave) * 64 + lane];
                modv[(i * 3 + wave) * NMOD + n] = s; }
            __syncthreads();
        } else if (bx == 200) {
            for (int e = tid; e < 4096; e += NTHR) { const int a = e >> 4, i = e & 15; const float inv = exp2f(-(float)i * (13.287712379549449f / 16.0f));
                double rev = (double)((float)a * inv) * 0.15915494309189535; rev -= rint(rev); const float fr = (float)rev;
                rope[e] = (f32x2){__builtin_amdgcn_cosf(fr), __builtin_amdgcn_sinf(fr)}; }
        }
        LAYER_WCONV(0, N_IN0);
    }
    SEAM(0);
    asm volatile("; ===PHASE 1");
    REP(1) if (IN(1)) { const int tid = opaque_tid(), lane = tid & 63; (void)tid; (void)lane; PHASE_PTRS norm_phase<false>(INP(I_X), INP(I_CTX), INP(I_N1G), modv, 0, Abuf, NROW, gw, ngw, lane); }
    SEAM(1);
    asm volatile("; ===PHASE 2");
    REP(2) if (IN(2)) { const int tid = opaque_tid(), lane = tid & 63; (void)tid; (void)lane; PHASE_PTRS
        pg8::Gemm g{Abuf, Wb + W_IN0 / 2, NROW, 2560, D, nullptr, 0}; pg8::StaticOrder S; S.init(NROW, 2560, G, bx);
        epi::EpiIn0 E{(float*)(big + B_P), (bf16_t*)(big + B_Q), (bf16_t*)(big + B_K), (bf16_t*)(big + B_V), rope, kmax2, ldsl + 144 * 1024};
        pg8::gemm_run<epi::EpiIn0, true, true>(ldsl, g, S, E);
    }
    SEAM(2);
    asm volatile("; ===PHASE 3");
    if (IN(3)) { const int tid = opaque_tid(), lane = tid & 63; (void)tid; (void)lane; PHASE_PTRS
        const bool conv_first3 = ((bx >> 3) & 1) == 0;
        if (conv_first3) { LAYER_WCONV(N_IN0, NITEMS); __syncthreads(); }
        const float* P = (const float*)(big + B_P); bf16_t* MIX = (bf16_t*)(big + B_MIX);
        for (int blk = gw; blk < NROW / 16; blk += ngw) {
            const int m0 = blk * 16;
            int sb, t0, L; if (m0 < NLAT) { sb = m0 & ~(SEQ - 1); t0 = m0 & (SEQ - 1); L = SEQ; } else { sb = NLAT + ((m0 - NLAT) & ~(CTX - 1)); t0 = (m0 - NLAT) & (CTX - 1); L = CTX; }
            f32x4 r[32];
#pragma unroll
            for (int j = 0; j < 32; ++j) { const int tt = t0 - 8 + j; const bool ok = (tt >= 0) && (tt < L);
                const f32x4 x = *(const f32x4*)(P + (size_t)(sb + (ok ? tt : t0)) * 256 + lane * 4); r[j] = ok ? x : (f32x4){0.f, 0.f, 0.f, 0.f}; }
            const int g = lane >> 4, half = 1 << g;
            f32x4 w1 = r[7] + r[8], w2 = w1 + (r[6] + r[9]), w4 = w2 + ((r[4] + r[5]) + (r[10] + r[11])), w8 = w4 + (((r[0] + r[1]) + (r[2] + r[3])) + ((r[12] + r[13]) + (r[14] + r[15])));
#pragma unroll
            for (int i = 0; i < 16; ++i) { const int t = t0 + i, tlo = max(t - half, 0), thi = min(t + half, L);
                const f32x4 s = (g == 0) ? w1 : (g == 1) ? w2 : (g == 2) ? w4 : w8;
                const float rc = 1.0f / (float)(thi - tlo);
                epi::st_bf4(MIX + (size_t)(m0 + i) * D + lane * 4, s * rc - r[i + 8]);
                if (i < 15) { w1 += r[i + 9] - r[i + 7]; w2 += r[i + 10] - r[i + 6]; w4 += r[i + 12] - r[i + 4]; w8 += r[i + 16] - r[i]; } }
        }
        float lam;
        { const float d1 = wave_sum(INP(I_LQ1)[lane] * INP(I_LK1)[lane]), d2 = wave_sum(INP(I_LQ2)[lane] * INP(I_LK2)[lane]); lam = expf(d1) - expf(d2) + LAM_INIT0; }
        const bf16_t* Qb = (const bf16_t*)(big + B_Q); const bf16_t* Kb = (const bf16_t*)(big + B_K); const bf16_t* Vb = (const bf16_t*)(big + B_V);
        const int r32 = lane & 31, hi = lane >> 5, map = wave >> 2, w4 = wave & 3;
        constexpr int NU_LAT = NB * 6 * (SEQ / 128), NU = NU_LAT + NB * 6 * (CTX / 128);
        const int vbx = (G == 256) ? ((bx & 7) * 32 + (bx >> 3)) : bx;
        for (int uu = vbx; uu < NU * ((REPEAT_PHASE == 3) ? 2 : 1); uu += G) { const int u = uu >= NU ? uu - NU : uu;
            int b, h, qrow0, lat0, nlt, ctx0, NT;
            if (u < NU_LAT) { const int qb = u & 127, bh = u >> 7; b = bh / 6; h = bh - b * 6; qrow0 = b * SEQ + qb * 128; lat0 = b * SEQ; nlt = SEQ / 64; ctx0 = NLAT + b * CTX; NT = nlt + CTX / 64; }
            else { const int v = u - NU_LAT, qb = v & 1, bh = v >> 1; b = bh / 6; h = bh - b * 6; qrow0 = NLAT + b * CTX + qb * 128; lat0 = 0; nlt = 0; ctx0 = NLAT + b * CTX; NT = CTX / 64; }
            const bf16_t* Qw = Qb + (size_t)(qrow0 + w4 * 32 + r32) * 768 + h * 128 + map * 64 + hi * 8;
            att::attn_unit<0>(Qw, Kb + h * 128, Vb + (size_t)h * 128 * NROW, nullptr, lat0, nlt, ctx0, NT, MIX + 256 + h * 128, qrow0, lam, (const float*)kmax2 + (b * 6 + h) * 4, nullptr, (char*)lds, ldsl);
        }
        if (!conv_first3) { __syncthreads(); LAYER_WCONV(N_IN0, NITEMS); }
#ifdef SHADOW_VAR
        for (int u = bx; u < NU; u += G) {
            int b, h, qrow0, lat0, nlt, ctx0, NT;
            if (u < NU_LAT) { const int qb = u & 127, bh = u >> 7; b = bh / 6; h = bh - b * 6; qrow0 = b * SEQ + qb * 128; lat0 = b * SEQ; nlt = SEQ / 64; ctx0 = NLAT + b * CTX; NT = nlt + CTX / 64; }
            else { const int v = u - NU_LAT, qb = v & 1, bh = v >> 1; b = bh / 6; h = bh - b * 6; qrow0 = NLAT + b * CTX + qb * 128; lat0 = 0; nlt = 0; ctx0 = NLAT + b * CTX; NT = CTX / 64; }
            const bf16_t* Qw = Qb + (size_t)(qrow0 + w4 * 32 + r32) * 768 + h * 128 + map * 64 + hi * 8;
            att::attn_unit<0, SHADOW_VAR>(Qw, Kb + h * 128, Vb + (size_t)h * 128 * NROW, nullptr, lat0, nlt, ctx0, NT, (bf16_t*)(big + B_XS) + 256 + h * 128, qrow0, lam, (const float*)kmax2 + (b * 6 + h) * 4, nullptr, (char*)lds, ldsl);
        }
#endif
    }
    SEAM(3);
    asm volatile("; ===PHASE 4");
    REP(4) if (IN(4)) { const int tid = opaque_tid(), lane = tid & 63; (void)tid; (void)lane; PHASE_PTRS
        pg8::Gemm g{(const bf16_t*)(big + B_MIX), Wb + W_OUT0 / 2, NROW, D, D, nullptr, 0}; pg8::StaticOrder S; S.init(NROW, D, G, bx);
        epi::EpiRes<false> E{INP(I_X), HS, INP(I_CTX), HC, modv + 2 * D};
        pg8::gemm_run<epi::EpiRes<false>, true, true>(ldsl, g, S, E);
#if TAIL_PROBE == 4
        for (int rp_ = 0; rp_ < 4; ++rp_) pg8::gemm_tail<epi::EpiRes<false>>(ldsl, g, S, E);
#endif
    }
    SEAM(4);
    asm volatile("; ===PHASE 5");
    REP(5) if (IN(5)) { const int tid = opaque_tid(), lane = tid & 63; (void)tid; (void)lane; PHASE_PTRS norm_phase<true>(HS, HC, INP(I_N2G), modv, 3, Abuf, NROW, gw, ngw, lane);
#if REPEAT_PHASE == 105
        norm_phase<true>(HS, HC, INP(I_N2G), modv, 3, Abuf, NROW, gw, ngw, lane);
#endif
    }
    SEAM(5);
    asm volatile("; ===PHASE 6");
    REP(6) if (IN(6)) { const int tid = opaque_tid(), lane = tid & 63; (void)tid; (void)lane; PHASE_PTRS
        pg8::Gemm g{Abuf, Wb + W_GU0 / 2, NROW, 2 * FF, D, nullptr, 0}; pg8::StaticOrder S; S.init(NROW, 2 * FF, G, bx);
        epi::EpiGU E{(bf16_t*)(big + B_HID)};
        pg8::gemm_run<epi::EpiGU, true, true>(ldsl, g, S, E);
#if TAIL_PROBE == 6
        for (int rp_ = 0; rp_ < 4; ++rp_) pg8::gemm_tail<epi::EpiGU>(ldsl, g, S, E);
#endif
    }
    SEAM(6);
    asm volatile("; ===PHASE 7");
    REP(7) if (IN(7)) { const int tid = opaque_tid(), lane = tid & 63; (void)tid; (void)lane; PHASE_PTRS
        pg8::Gemm g{(const bf16_t*)(big + B_HID), Wb + W_DN0 / 2, NROW, D, FF, nullptr, 0}; pg8::StaticOrder S; S.init(NROW, D, G, bx);
        epi::EpiRes<true> E{HS, HS, HC, HC, modv + 5 * D};
        pg8::gemm_run<epi::EpiRes<true>, true, true>(ldsl, g, S, E);
    }
    SEAM(7);
    asm volatile("; ===PHASE 8");
    REP(8) if (IN(8)) { const int tid = opaque_tid(), lane = tid & 63; (void)tid; (void)lane; PHASE_PTRS norm_phase<true>(HS, HC, INP(I_N1G) + D, modv + 3 * NMOD, 0, Abuf, NROW, gw, ngw, lane); }
    SEAM(8);
    asm volatile("; ===PHASE 9");
    REP(9) if (IN(9)) { const int tid = opaque_tid(), lane = tid & 63; (void)tid; (void)lane; PHASE_PTRS
        pg8::Gemm g{Abuf, Wb + W_IN1 / 2, NROW, D, D, nullptr, 0}; pg8::StaticOrder S; S.init(NROW, D, G, bx);
        epi::EpiIn1 E{(bf16_t*)(big + B_CQ), (bf16_t*)(big + B_CKV), (bf16_t*)(big + B_KR), ssq_q, ssq_kv, rope, krmax2};
        pg8::gemm_run<epi::EpiIn1, true, true>(ldsl, g, S, E);
    }
    SEAM(9);
    asm volatile("; ===PHASE 10");
    REP(10) if (IN(10)) { const int tid = opaque_tid(), lane = tid & 63; (void)tid; (void)lane; PHASE_PTRS
        { pg8::Gemm g{(const bf16_t*)(big + B_CQ), Wb + W_UQ / 2, NLAT, 1536, 512, nullptr, 0}; pg8::StaticOrder S; S.init(NLAT, 1536, G, bx);
          epi::EpiUQ E{(bf16_t*)(big + B_Q1), ssq_q, rope};
          pg8::gemm_run<epi::EpiUQ, true, true>(ldsl, g, S, E); }
        { pg8::Gemm g{(const bf16_t*)(big + B_CKV), Wb + W_UKV / 2, NROW, 2048, 256, nullptr, 0}; pg8::StaticOrder S; S.init(NROW, 2048, G, bx);
          epi::EpiUKV E{(bf16_t*)(big + B_KV1), ssq_kv, knmax2, (bf16_t*)(big + B_VT1), ldsl + 144 * 1024};
          pg8::gemm_run<epi::EpiUKV, true, true>(ldsl, g, S, E); }
    }
    SEAM(10);
    asm volatile("; ===PHASE 11");
    REP(11) if (IN(11)) { const int tid = opaque_tid(), lane = tid & 63; (void)tid; (void)lane; PHASE_PTRS
        const bf16_t* Q1 = (const bf16_t*)(big + B_Q1); const bf16_t* KV1 = (const bf16_t*)(big + B_KV1); const bf16_t* KR = (const bf16_t*)(big + B_KR);
        const int r32 = lane & 31, hi = lane >> 5;
        constexpr int NU = NB * 8 * (SEQ / 256);
        const int vbx11 = (G == 256) ? ((bx & 7) * 32 + (bx >> 3)) : bx;
        for (int u = vbx11; u < NU; u += G) {
            const int qb = u & 63, bh = u >> 6, b = bh >> 3, h = bh & 7, qrow0 = b * SEQ + qb * 256;
            const bf16_t* Qw = Q1 + (size_t)(qrow0 + wave * 32 + r32) * 1536 + h * 192 + hi * 8;
            att::attn_unit<1>(Qw, KV1 + h * 256, (const bf16_t*)(big + B_VT1) + (size_t)h * 128 * NROW, KR, b * SEQ, SEQ / 64, NLAT + b * CTX, SEQ / 64 + CTX / 64, Abuf + h * 128, qrow0, 0.f, (const float*)knmax2 + (b * 8 + h) * 4, (const float*)krmax2 + b * 2, (char*)lds, ldsl);
        }
    }
    SEAM(11);
#define MOE_WCONV() do { LAS float* scr = (LAS float*)(ldsl + wave * 16384); bf16_t* WM = (bf16_t*)(big + B_WM); \
        constexpr int N_G = 16 * 88, N_D = 44 * 32, PER_E = 2 * N_G + N_D; \
        for (int it = gw; it < NEXP * PER_E; it += ngw) { \
            const int e = it / PER_E; int r = it - e * PER_E; bf16_t* we = WM + (size_t)e * ESTRIDE; \
            if (r < N_G) { tr_item(INP(I_MG) + (size_t)e * D * FF, FF, r, nullptr, we, D, 1, scr, lane); continue; } r -= N_G; \
            if (r < N_G) { tr_item(INP(I_MU) + (size_t)e * D * FF, FF, r, nullptr, we, D, 2, scr, lane); continue; } r -= N_G; \
            tr_item(INP(I_MD) + (size_t)e * FF * D, D, r, nullptr, we + (size_t)2 * FF * D, FF, 0, scr, lane); } } while (0)
    asm volatile("; ===PHASE 12");
    REP(12) if (IN(12)) { const int tid = opaque_tid(), lane = tid & 63; (void)tid; (void)lane; PHASE_PTRS
        pg8::Gemm g{Abuf, Wb + W_OUT1 / 2, NLAT, D, D, nullptr, 0}; pg8::StaticOrder S; S.init(NLAT, D, G, bx);
        epi::EpiRes<true> E{HS, HS, HC, HC, modv + 3 * NMOD + 2 * D};
        const bool conv_first = ((bx >> 3) & 1) == 0;
        if (conv_first) { MOE_WCONV(); __syncthreads(); }
        pg8::gemm_run<epi::EpiRes<true>, true, true>(ldsl, g, S, E);
        if (!conv_first) { __syncthreads(); MOE_WCONV(); }
    }
    SEAM(12);
    asm volatile("; ===PHASE 13");
    if (IN(13)) { const int tid = opaque_tid(), lane = tid & 63; (void)tid; (void)lane; PHASE_PTRS
        volatile LAS int* re = (volatile LAS int*)(ldsl + MISC_OFF + 256);
        volatile LAS float* rw = (volatile LAS float*)(ldsl + MISC_OFF + 256 + 1024);
        {
            f32x4 rwr[4][4][2];
#pragma unroll
            for (int j = 0; j < 4; ++j)
#pragma unroll
                for (int c = 0; c < 4; ++c) { const float* p = INP(I_RTW) + (size_t)(4 * (64 * j + lane) + c) * 8; rwr[j][c][0] = *(const f32x4*)p; rwr[j][c][1] = *(const f32x4*)(p + 4); }
            const float* mv = modv + 3 * NMOD + ((bx * 128) >> 14) * NMOD; const float* ng2 = INP(I_N2G) + D;
            f32x4 gm[4], sv[4];
#pragma unroll
            for (int j = 0; j < 4; ++j) { gm[j] = ((const f32x4*)ng2)[64 * j + lane] * (((const f32x4*)(mv + 4 * D))[64 * j + lane] + 1.0f); sv[j] = ((const f32x4*)(mv + 3 * D))[64 * j + lane]; }
            for (int it = 0; it < 16; it += 2) {
                const int tl = wave * 16 + it, m = bx * 128 + tl;
                const u32x2* x0 = (const u32x2*)(HS + (size_t)m * D) + lane; const u32x2* x1 = x0 + D / 4;
                f32x4 a[2][4]; float ss[2] = {0.f, 0.f}; u32x2 ra[2][4];
#pragma unroll
                for (int j = 0; j < 4; ++j) { ra[0][j] = x0[64 * j]; ra[1][j] = x1[64 * j]; }
#pragma unroll
                for (int j = 0; j < 4; ++j) { a[0][j] = epi::bf4_f(ra[0][j].x, ra[0][j].y); a[1][j] = epi::bf4_f(ra[1][j].x, ra[1][j].y); }
#pragma unroll
                for (int q = 0; q < 2; ++q)
#pragma unroll
                    for (int j = 0; j < 4; ++j) ss[q] += (a[q][j][0] * a[q][j][0] + a[q][j][1] * a[q][j][1]) + (a[q][j][2] * a[q][j][2] + a[q][j][3] * a[q][j][3]);
#pragma unroll
                for (int o = 1; o < 64; o <<= 1) { ss[0] += __shfl_xor(ss[0], o); ss[1] += __shfl_xor(ss[1], o); }
                float k1[2];
#pragma unroll
                for (int q = 0; q < 2; ++q) { const float r = 1.0f / sqrtf(ss[q] * (1.0f / D) + EPS); u32x2* o8 = (u32x2*)(Abuf + (size_t)(m + q) * D) + lane;
                    f32x4 l0 = {0.f, 0.f, 0.f, 0.f}, l1 = {0.f, 0.f, 0.f, 0.f};
#pragma unroll
                    for (int j = 0; j < 4; ++j) { const f32x4 y = (a[q][j] * r) * gm[j] + sv[j]; u32x2 w; w.x = cvtpk(y[0], y[1]); w.y = cvtpk(y[2], y[3]); o8[64 * j] = w;
#pragma unroll
                        for (int c = 0; c < 4; ++c) { l0 += rwr[j][c][0] * y[c]; l1 += rwr[j][c][1] * y[c]; } }
                    const bool h5 = (lane & 32) != 0, h4 = (lane & 16) != 0, h3 = (lane & 8) != 0; float k4[4], k2[2];
#pragma unroll
                    for (int i = 0; i < 4; ++i) { const float mine = h5 ? l1[i] : l0[i], send = h5 ? l0[i] : l1[i]; k4[i] = mine + __shfl_xor(send, 32); }
#pragma unroll
                    for (int i = 0; i < 2; ++i) { const float mine = h4 ? k4[2 + i] : k4[i], send = h4 ? k4[i] : k4[2 + i]; k2[i] = mine + __shfl_xor(send, 16); }
                    { const float mine = h3 ? k2[1] : k2[0], send = h3 ? k2[0] : k2[1]; k1[q] = mine + __shfl_xor(send, 8); }
                    k1[q] += __shfl_xor(k1[q], 4); k1[q] += __shfl_xor(k1[q], 2); k1[q] += __shfl_xor(k1[q], 1); }
#pragma unroll
                for (int q = 0; q < 2; ++q) { float lg[8];
#pragma unroll
                    for (int e = 0; e < 8; ++e) lg[e] = __uint_as_float(__builtin_amdgcn_readlane(__float_as_uint(k1[q]), 32 * (e >> 2) + 16 * ((e >> 1) & 1) + 8 * (e & 1)));
                    int e1 = 0; float m1 = lg[0];
#pragma unroll
                    for (int e = 1; e < 8; ++e) if (lg[e] > m1) { m1 = lg[e]; e1 = e; }
                    int e2 = -1; float m2 = -3.0e38f;
#pragma unroll
                    for (int e = 0; e < 8; ++e) if (e != e1 && lg[e] > m2) { m2 = lg[e]; e2 = e; }
                    const float x2 = expf(m2 - m1), w1 = 1.0f / (1.0f + x2), w2 = x2 / (1.0f + x2);
                    if (lane == 0) { re[tl + q] = e1; re[128 + tl + q] = e2; rw[tl + q] = w1; rw[128 + tl + q] = w2; } }
            }
        }
        __syncthreads();
        if (wave < 2 && G == 256) {
            const int s = wave; const int ea = re[s * 128 + lane], eb = re[s * 128 + 64 + lane]; const float wa = rw[s * 128 + lane], wb = rw[s * 128 + 64 + lane];
            const unsigned long long ltm = (1ull << lane) - 1ull;
#pragma unroll
            for (int e = 0; e < 8; ++e) {
                const unsigned long long ma = __ballot(ea == e), mb = __ballot(eb == e);
                const int ca = __popcll(ma), cb = __popcll(mb);
                int base = 0; if (lane == 0 && ca + cb > 0) base = (int)atomicAdd(ctl + CW_CNT + 64 * (s * 8 + e), (unsigned)(ca + cb));
                base = __builtin_amdgcn_readfirstlane(base);
                if (ea == e) { const int pos = base + __popcll(ma & ltm); midx[(size_t)(s * 8 + e) * NLAT + pos] = bx * 128 + lane; mwgt[(size_t)(s * 8 + e) * NLAT + pos] = wa; }
                if (eb == e) { const int pos = base + ca + __popcll(mb & ltm); midx[(size_t)(s * 8 + e) * NLAT + pos] = bx * 128 + 64 + lane; mwgt[(size_t)(s * 8 + e) * NLAT + pos] = wb; }
            }
        }
    }
    SEAM(13);
#define MOE_PREFIX(s) do { __syncthreads(); if (tid < 8) MISC[32 + tid] = __hip_atomic_load(ctl + CW_CNT + 64 * ((s) * 8 + tid), __ATOMIC_RELAXED, __HIP_MEMORY_SCOPE_AGENT); __syncthreads(); \
        if (tid == 0) { int acc_ = 0; for (int e = 0; e < 8; ++e) { MISC[16 + e] = (unsigned)acc_; acc_ += ((int)MISC[32 + e] + 255) >> 8; } MISC[16 + 8] = (unsigned)acc_; } __syncthreads(); } while (0)
#define MOE_GATHER(s) do { const int np_ = (int)MISC[16 + 8]; bf16_t* XS = (bf16_t*)(big + B_XS); \
        for (int r0_ = gw * 4; r0_ < np_ * 256; r0_ += ngw * 4) { int tok_[4]; \
            _Pragma("unroll") for (int q_ = 0; q_ < 4; ++q_) { const int r_ = r0_ + q_; const int pm_ = r_ >> 8; int e_ = 0; for (int k = 1; k < 8; ++k) e_ += (pm_ >= (int)MISC[16 + k]) ? 1 : 0; \
                const int pos_ = r_ - ((int)MISC[16 + e_] << 8); tok_[q_] = pos_ < (int)MISC[32 + e_] ? midx[(size_t)((s) * 8 + e_) * NLAT + pos_] : 0; } \
            u32x4 d_[4][2]; \
            _Pragma("unroll") for (int q_ = 0; q_ < 4; ++q_) { const u32x4* src_ = (const u32x4*)(Abuf + (size_t)tok_[q_] * D); d_[q_][0] = src_[lane]; d_[q_][1] = src_[64 + lane]; } \
            _Pragma("unroll") for (int q_ = 0; q_ < 4; ++q_) { u32x4* dst_ = (u32x4*)(XS + (size_t)(r0_ + q_) * D); dst_[lane] = d_[q_][0]; dst_[64 + lane] = d_[q_][1]; } } } while (0)
#define MOE_GU(s) do { const int np_ = (int)MISC[16 + 8]; pg8::Gemm g{Abuf, (const bf16_t*)(big + B_WM), np_ * 256, 2 * FF, D, (const volatile LAS int*)(MISC + 16), ESTRIDE, midx + (size_t)(s) * 8 * NLAT, (const volatile LAS int*)(MISC + 32)}; \
        pg8::StaticOrder S; S.init(np_ * 256, 2 * FF, G, bx); epi::EpiGU E{(bf16_t*)(big + B_HIDM)}; pg8::gemm_run<epi::EpiGU, true, true, true>(ldsl, g, S, E); } while (0)
#define MOE_DOWN(s) do { const int np_ = (int)MISC[16 + 8]; pg8::Gemm g{(const bf16_t*)(big + B_HIDM), (const bf16_t*)(big + B_WM) + (size_t)2 * FF * D, np_ * 256, D, FF, (const volatile LAS int*)(MISC + 16), ESTRIDE}; \
        pg8::StaticOrder S; S.init(np_ * 256, D, G, bx); epi::EpiMoeDown E{HS, (s) == 1 ? Abuf : HS, modv + 3 * NMOD + 5 * D, midx + (size_t)(s) * 8 * NLAT, mwgt + (size_t)(s) * 8 * NLAT, (const volatile LAS int*)(MISC + 16), (const volatile LAS int*)(MISC + 32)}; \
        pg8::gemm_run<epi::EpiMoeDown, true, true>(ldsl, g, S, E); } while (0)
    asm volatile("; ===PHASE 15");
    REP(15) if (IN(15)) { const int tid = opaque_tid(), lane = tid & 63; (void)tid; (void)lane; PHASE_PTRS MOE_PREFIX(0); MOE_GU(0); }
    SEAM(15);
    asm volatile("; ===PHASE 16");
    REP(16) if (IN(16)) { const int tid = opaque_tid(), lane = tid & 63; (void)tid; (void)lane; PHASE_PTRS MOE_PREFIX(0); MOE_DOWN(0); }
    SEAM(16);
    asm volatile("; ===PHASE 17");
    REP(17) if (IN(17)) { const int tid = opaque_tid(), lane = tid & 63; (void)tid; (void)lane; PHASE_PTRS MOE_PREFIX(1); MOE_GU(1); }
    SEAM(17);
    asm volatile("; ===PHASE 18");
    REP(18) if (IN(18)) { const int tid = opaque_tid(), lane = tid & 63; (void)tid; (void)lane; PHASE_PTRS MOE_PREFIX(1); MOE_DOWN(1); }
    SEAM(18);
    asm volatile("; ===PHASE 19");
    REP(19) if (IN(19)) { const int tid = opaque_tid(), lane = tid & 63; (void)tid; (void)lane; PHASE_PTRS
        const float* fg = INP(I_FNG); float* out19 = OUT;
        f32x4 fgv[4];
#pragma unroll
        for (int j = 0; j < 4; ++j) fgv[j] = ((const f32x4*)fg)[64 * j + lane];
        for (int m = gw * 2; m < NLAT; m += ngw * 2) {
            f32x4* x0 = (f32x4*)(out19 + (size_t)m * D) + lane; f32x4* x1 = x0 + D / 4; f32x4 a[4], b[4]; float s0 = 0.f, s1 = 0.f;
            const u32x2* y0 = (const u32x2*)(Abuf + (size_t)m * D) + lane; const u32x2* y1 = y0 + D / 4; u32x2 ra[4], rb[4];
#pragma unroll
            for (int j = 0; j < 4; ++j) { ra[j] = y0[64 * j]; rb[j] = y1[64 * j]; }
#pragma unroll
            for (int j = 0; j < 4; ++j) { a[j] = epi::bf4_f(ra[j].x, ra[j].y); b[j] = epi::bf4_f(rb[j].x, rb[j].y); }
#pragma unroll
            for (int j = 0; j < 4; ++j) { s0 += (a[j][0] * a[j][0] + a[j][1] * a[j][1]) + (a[j][2] * a[j][2] + a[j][3] * a[j][3]); s1 += (b[j][0] * b[j][0] + b[j][1] * b[j][1]) + (b[j][2] * b[j][2] + b[j][3] * b[j][3]); }
#pragma unroll
            for (int o = 1; o < 64; o <<= 1) { s0 += __shfl_xor(s0, o); s1 += __shfl_xor(s1, o); }
            const float r0 = 1.0f / sqrtf(s0 * (1.0f / D) + EPS), r1 = 1.0f / sqrtf(s1 * (1.0f / D) + EPS);
#pragma unroll
            for (int j = 0; j < 4; ++j) { x0[64 * j] = a[j] * r0 * fgv[j]; x1[64 * j] = b[j] * r1 * fgv[j]; }
        }
    }
#undef IN
#undef SEAM
}

#ifndef N_LAUNCH_MODE
#define N_LAUNCH_MODE 1
#endif
extern "C" void kernel_launch(void* const* d_in, const int* in_sizes, int n_in, void* d_out, int out_size, void* d_ws, size_t ws_size, hipStream_t stream) {
    static int grid = 0;
    if (grid == 0) {
        if (n_in != 30 || out_size != NLAT * D || ws_size < WS_END) { fprintf(stderr, "kernel_launch: unexpected shapes: n_in %d out %d ws %zu (need %zu)\n", n_in, out_size, ws_size, (size_t)WS_END); grid = -1; return; }
        int dev = 0, cus = 0, per_cu = 0;
        if (hipGetDevice(&dev) != hipSuccess || hipDeviceGetAttribute(&cus, hipDeviceAttributeMultiprocessorCount, dev) != hipSuccess) { grid = -1; return; }
        if (hipFuncSetAttribute((const void*)fwd_kernel, hipFuncAttributeMaxDynamicSharedMemorySize, LDS_BYTES) != hipSuccess) { fprintf(stderr, "kernel_launch: hipFuncSetAttribute failed\n"); grid = -1; return; }
        if (hipOccupancyMaxActiveBlocksPerMultiprocessor(&per_cu, (const void*)fwd_kernel, NTHR, LDS_BYTES) != hipSuccess || per_cu < 1) fprintf(stderr, "kernel_launch: occupancy query reports %d\n", per_cu);
        (void)hipGetLastError();
        grid = cus;
        if (grid != 256) { fprintf(stderr, "kernel_launch: built for 256 CUs, found %d\n", grid); grid = -1; return; }
    }
    if (grid < 0) return;
    if (hipMemsetAsync((char*)d_ws + WS_CTL, 0, CTL_ZERO_BYTES, stream) != hipSuccess) return;
    Args a{};
    for (int i = 0; i < 30; ++i) a.in[i] = (const float*)d_in[i];
    a.out = (float*)d_out; a.ws = (unsigned char*)d_ws;
    constexpr int NPH = 20;
    if (N_LAUNCH_MODE == 1) { a.ph_lo = 0; a.ph_hi = NPH; hipLaunchKernelGGL(fwd_kernel, dim3(grid), dim3(NTHR), LDS_BYTES, stream, a); }
    else { for (int p = 0; p < NPH; ++p) { a.ph_lo = p; a.ph_hi = p + 1; hipLaunchKernelGGL(fwd_kernel, dim3(grid), dim3(NTHR), LDS_BYTES, stream, a); } }
    const hipError_t le = hipPeekAtLastError();
    if (le != hipSuccess) fprintf(stderr, "kernel_launch: launch failed: %s\n", hipGetErrorName(le));
}
```
